# Optimizing an MI355X kernel written in HIP

```python
import math
import jax, jax.numpy as jnp
from jax import lax
import numpy as np

D_MODEL = 1024
BATCH = 2
SEQ = 8192
DEPTH = 4

N_MIXERS = 3
N_A = (DEPTH + 2) // 3
N_B = (DEPTH + 1) // 3
N_C = DEPTH // 3

CONV_WIDTH = 3

RET_HEADS = 4
RET_DK = D_MODEL // RET_HEADS
RET_DV = 2 * RET_DK
RET_VDIM = RET_HEADS * RET_DV
RET_CHUNK = 128
ROPE_BASE = 10000.0

SGU_HALF = 3 * D_MODEL
SGU_GROUPS = 4
SGU_GD = SGU_HALF // SGU_GROUPS
SGU_CHUNK = 128

N_EXPERTS = 16
N_GROUPS = 4
EXPERTS_PER_GROUP = N_EXPERTS // N_GROUPS
TOP_K = 2
D_EXPERT = D_MODEL // 2

PLE_DIM = 256
ALPHA = (2 * DEPTH) ** 0.25
BETA = (8 * DEPTH) ** -0.25
LN_EPS = 1e-5

kernel_name = "hybrid_conv_retention_sgu_moe_deepnorm"


def _layer_norm(x, g, b):
    xf = x.astype(jnp.float32)
    mu = jnp.mean(xf, axis=-1, keepdims=True)
    xc = xf - mu
    var = jnp.mean(xc * xc, axis=-1, keepdims=True)
    return (xc * lax.rsqrt(var + LN_EPS) * g + b).astype(x.dtype)


def _short_conv_mixer(x, w_in, conv_w, w_out):
    bch = x @ w_in
    b_gate, c_gate, h = jnp.split(bch, 3, axis=-1)
    z = c_gate * h
    zc = lax.conv_general_dilated(
        z, conv_w[:, None, :].astype(z.dtype),
        window_strides=(1,), padding=[(CONV_WIDTH - 1, 0)],
        dimension_numbers=("NWC", "WIO", "NWC"),
        feature_group_count=D_MODEL)
    return (b_gate * zc) @ w_out


def _rotary(t, cos, sin):
    t1, t2 = jnp.split(t, 2, axis=-1)
    return jnp.concatenate([t1 * cos - t2 * sin, t2 * cos + t1 * sin], axis=-1)


def _retention_mixer(x, w_in, w_out):
    bsz, seq, _ = x.shape
    n_chunks = seq // RET_CHUNK
    proj = x @ w_in
    q, k, v, g = jnp.split(proj, [D_MODEL, 2 * D_MODEL, 2 * D_MODEL + RET_VDIM], axis=-1)
    q = q.astype(jnp.float32).reshape(bsz, seq, RET_HEADS, RET_DK)
    k = k.astype(jnp.float32).reshape(bsz, seq, RET_HEADS, RET_DK) * (RET_DK ** -0.5)
    v = v.astype(jnp.float32).reshape(bsz, seq, RET_HEADS, RET_DV)

    pos = jnp.arange(seq, dtype=jnp.float32)
    inv_freq = 1.0 / (ROPE_BASE ** jnp.linspace(0.0, 1.0, RET_DK // 2, dtype=jnp.float32))
    ang = pos[:, None] * inv_freq[None, :]
    cos = jnp.cos(ang)[:, None, :]
    sin = jnp.sin(ang)[:, None, :]
    q = _rotary(q, cos, sin)
    k = _rotary(k, cos, sin)

    def to_chunks(t):
        return t.reshape(bsz, n_chunks, RET_CHUNK, RET_HEADS, -1).transpose(1, 0, 3, 2, 4)
    qc, kc, vc = to_chunks(q), to_chunks(k), to_chunks(v)

    log_gamma = jnp.log(1.0 - 2.0 ** (-5.0 - jnp.arange(RET_HEADS, dtype=jnp.float32)))
    idx = jnp.arange(RET_CHUNK, dtype=jnp.float32)
    diff = idx[:, None] - idx[None, :]
    decay_mask = jnp.where(diff >= 0,
                           jnp.exp(log_gamma[:, None, None] * jnp.maximum(diff, 0.0)), 0.0)
    q_decay = jnp.exp(log_gamma[:, None] * (idx[None, :] + 1.0))
    k_decay = jnp.exp(log_gamma[:, None] * (RET_CHUNK - 1.0 - idx[None, :]))
    chunk_decay = jnp.exp(log_gamma * RET_CHUNK)

    scores = jnp.einsum("nbhcd,nbhsd->nbhcs", qc, kc) * decay_mask[None, None]
    inner = jnp.einsum("nbhcs,nbhse->nbhce", scores, vc)

    def step(state, inp):
        q_i, k_i, v_i = inp
        cross = jnp.einsum("bhcd,bhde->bhce", q_i, state) * q_decay[None, :, :, None]
        state = state * chunk_decay[None, :, None, None] + jnp.einsum(
            "bhcd,bhce->bhde", k_i * k_decay[None, :, :, None], v_i)
        return state, cross
    state0 = jnp.zeros((bsz, RET_HEADS, RET_DK, RET_DV), jnp.float32)
    _, cross = lax.scan(step, state0, (qc, kc, vc))

    o = (inner + cross).transpose(1, 0, 3, 2, 4).reshape(bsz, seq, RET_HEADS, RET_DV)
    mu = jnp.mean(o, axis=-1, keepdims=True)
    oc = o - mu
    o = oc * lax.rsqrt(jnp.mean(oc * oc, axis=-1, keepdims=True) + LN_EPS)
    o = o.reshape(bsz, seq, RET_VDIM).astype(x.dtype)
    return (jax.nn.silu(g) * o) @ w_out


def _sgu_mixer(x, w_in, ln_g, ln_b, w_s, b_s, w_out):
    bsz, seq, _ = x.shape
    n_chunks = seq // SGU_CHUNK
    z = jax.nn.gelu(x @ w_in, approximate=False)
    u, v = jnp.split(z, 2, axis=-1)
    v = _layer_norm(v, ln_g, ln_b).reshape(bsz, n_chunks, SGU_CHUNK, SGU_GROUPS, SGU_GD)
    causal = jnp.tril(jnp.ones((SGU_CHUNK, SGU_CHUNK), w_s.dtype))
    ws = w_s * causal[None]
    vs = jnp.einsum("gts,bnsgd->bntgd", ws, v) + b_s.T[None, None, :, :, None]
    return (u * vs.reshape(bsz, seq, SGU_HALF)) @ w_out


def _moe(h, router_w, router_b, w_gate, w_up, w_down):
    bsz, seq, d = h.shape
    hf = h.reshape(bsz * seq, d)
    scores = jax.nn.sigmoid((hf @ router_w).astype(jnp.float32))
    sel = scores + router_b.astype(jnp.float32)
    grp = lax.top_k(sel.reshape(-1, N_GROUPS, EXPERTS_PER_GROUP), 2)[0].sum(-1)
    g_idx = jnp.argmax(grp, axis=-1)
    in_group = (jnp.arange(N_EXPERTS) // EXPERTS_PER_GROUP)[None, :] == g_idx[:, None]
    _, e_idx = lax.top_k(jnp.where(in_group, sel, -jnp.inf), TOP_K)
    w = jnp.take_along_axis(scores, e_idx, axis=-1)
    w = w / jnp.sum(w, axis=-1, keepdims=True)
    combine = jnp.sum(jax.nn.one_hot(e_idx, N_EXPERTS, dtype=jnp.float32) * w[..., None],
                      axis=1).astype(h.dtype)
    y = jnp.zeros_like(hf)
    for e in range(N_EXPERTS):
        he = jax.nn.silu(hf @ w_gate[e]) * (hf @ w_up[e])
        y = y + combine[:, e:e + 1] * (he @ w_down[e])
    return y.reshape(bsz, seq, d)


def setup_inputs(seed: int = 0) -> dict:
    key = jax.random.key(seed)
    ks = jax.random.split(key, 24)

    def nrm(k, shape, scale):
        return jax.random.normal(k, shape, jnp.float32) * scale

    return {
        "x": nrm(ks[0], (BATCH, SEQ, D_MODEL), 1.0),
        "p": nrm(ks[1], (DEPTH, BATCH, SEQ, PLE_DIM), 1.0),
        "a_w_in": nrm(ks[2], (N_A, D_MODEL, 3 * D_MODEL), D_MODEL ** -0.5),
        "a_conv_w": nrm(ks[3], (N_A, CONV_WIDTH, D_MODEL), CONV_WIDTH ** -0.5),
        "a_w_out": nrm(ks[4], (N_A, D_MODEL, D_MODEL), D_MODEL ** -0.5 * BETA),
        "b_w_in": nrm(ks[5], (N_B, D_MODEL, 2 * D_MODEL + 2 * RET_VDIM), D_MODEL ** -0.5),
        "b_w_out": nrm(ks[6], (N_B, RET_VDIM, D_MODEL), RET_VDIM ** -0.5 * BETA),
        "c_w_in": nrm(ks[7], (N_C, D_MODEL, 2 * SGU_HALF), D_MODEL ** -0.5),
        "c_ln_g": 1.0 + nrm(ks[8], (N_C, SGU_HALF), 0.02),
        "c_ln_b": nrm(ks[9], (N_C, SGU_HALF), 0.02),
        "c_w_s": nrm(ks[10], (N_C, SGU_GROUPS, SGU_CHUNK, SGU_CHUNK), 0.5 * SGU_CHUNK ** -0.5),
        "c_b_s": 1.0 + nrm(ks[11], (N_C, SGU_GROUPS, SGU_CHUNK), 0.1),
        "c_w_out": nrm(ks[12], (N_C, SGU_HALF, D_MODEL), SGU_HALF ** -0.5 * BETA),
        "router_w": nrm(ks[13], (D_MODEL, N_EXPERTS), D_MODEL ** -0.5),
        "router_b": nrm(ks[14], (N_EXPERTS,), 0.01),
        "moe_w_gate": nrm(ks[15], (DEPTH, N_EXPERTS, D_MODEL, D_EXPERT), D_MODEL ** -0.5),
        "moe_w_up": nrm(ks[16], (DEPTH, N_EXPERTS, D_MODEL, D_EXPERT), D_MODEL ** -0.5),
        "moe_w_down": nrm(ks[17], (DEPTH, N_EXPERTS, D_EXPERT, D_MODEL), D_EXPERT ** -0.5 * BETA),
        "ln_g": 1.0 + nrm(ks[18], (DEPTH, 2, D_MODEL), 0.02),
        "ln_b": nrm(ks[19], (DEPTH, 2, D_MODEL), 0.02),
        "ple_w_proj": nrm(ks[20], (DEPTH, PLE_DIM, D_MODEL), PLE_DIM ** -0.5),
        "ple_w_gate": nrm(ks[21], (DEPTH, D_MODEL, D_MODEL), D_MODEL ** -0.5),
        "ple_b_gate": nrm(ks[22], (DEPTH, D_MODEL), 0.02),
    }


def reference(x, p, a_w_in, a_conv_w, a_w_out, b_w_in, b_w_out, c_w_in, c_ln_g, c_ln_b,
              c_w_s, c_b_s, c_w_out, router_w, router_b, moe_w_gate, moe_w_up, moe_w_down,
              ln_g, ln_b, ple_w_proj, ple_w_gate, ple_b_gate):
    for i in range(DEPTH):
        mixer, slot = i % N_MIXERS, i // N_MIXERS
        if mixer == 0:
            mix = _short_conv_mixer(x, a_w_in[slot], a_conv_w[slot], a_w_out[slot])
        elif mixer == 1:
            mix = _retention_mixer(x, b_w_in[slot], b_w_out[slot])
        else:
            mix = _sgu_mixer(x, c_w_in[slot], c_ln_g[slot], c_ln_b[slot],
                             c_w_s[slot], c_b_s[slot], c_w_out[slot])
        x = _layer_norm(ALPHA * x + mix, ln_g[i, 0], ln_b[i, 0])
        ffn = _moe(x, router_w, router_b, moe_w_gate[i], moe_w_up[i], moe_w_down[i])
        x = _layer_norm(ALPHA * x + ffn, ln_g[i, 1], ln_b[i, 1])
        emb = p[i] @ ple_w_proj[i]
        gate = jax.nn.sigmoid(x @ ple_w_gate[i] + ple_b_gate[i])
        x = x + gate * emb
    return x
```

```cpp
#include <hip/hip_runtime.h>
#include <cstdio>
#include <cstdint>

#ifndef MK_MULTI
#define MK_MULTI 0
#endif

#define LAS __attribute__((address_space(3)))
#define GAS __attribute__((address_space(1)))
#define DI __device__ __forceinline__
typedef unsigned short bf16_t;
typedef short bf16x8 __attribute__((ext_vector_type(8)));
typedef float f32x4 __attribute__((ext_vector_type(4)));
typedef float f32x2 __attribute__((ext_vector_type(2)));
typedef unsigned u32x4 __attribute__((ext_vector_type(4)));
typedef unsigned u32x2 __attribute__((ext_vector_type(2)));
typedef __bf16 bf16x2v __attribute__((ext_vector_type(2)));

constexpr int NB = 2, SEQ = 8192, M = NB * SEQ, D = 1024, DEPTH = 4;
constexpr int CH = 128, NCHUNK = M / CH;
constexpr int RH = 4, DK = 256, DV = 512, VD = 2048;
constexpr int SH = 3072, SGD = 768;
constexpr int NE = 16, DE = 512;
constexpr int PLE = 256;
constexpr float ALPHA = 1.6817928305074290f;
constexpr float LN_EPS = 1e-5f;
constexpr int MAXTILES = 144;
constexpr int NSLOT = MAXTILES * 256;

DI unsigned pk2(float lo, float hi) { f32x2 v = {lo, hi}; bf16x2v r = __builtin_convertvector(v, bf16x2v); return __builtin_bit_cast(unsigned, r); }
DI float bf_lo(unsigned w) { return __uint_as_float(w << 16); }
DI float bf_hi(unsigned w) { return __uint_as_float(w & 0xffff0000u); }
DI unsigned short bf1(float x) { return (unsigned short)(pk2(x, 0.f) & 0xffffu); }
DI float bfr(float x) { return bf_lo(pk2(x, 0.f)); }
DI u32x4 pk8(f32x4 a, f32x4 b) { u32x4 w; w.x = pk2(a[0], a[1]); w.y = pk2(a[2], a[3]); w.z = pk2(b[0], b[1]); w.w = pk2(b[2], b[3]); return w; }
DI void unpk8(u32x4 w, f32x4& a, f32x4& b) { a = (f32x4){bf_lo(w.x), bf_hi(w.x), bf_lo(w.y), bf_hi(w.y)}; b = (f32x4){bf_lo(w.z), bf_hi(w.z), bf_lo(w.w), bf_hi(w.w)}; }
DI size_t tl16(size_t r, int c, int cols) { return ((r >> 4) * (size_t)(cols >> 3) + (size_t)(c >> 3)) * 128 + (r & 15) * 8 + (c & 7); }
DI size_t tl16t(size_t chunk, int rows, int erow, int s) { return (chunk * rows + (size_t)(erow & ~15)) * 128 + (size_t)(s >> 3) * 128 + (erow & 15) * 8 + (s & 7); }
DI int sig32(int d) { return (d & ~31) + 16 * ((d >> 2) & 1) + 4 * ((d >> 3) & 3) + (d & 3); }
DI float sigmoidf_(float x) { return __builtin_amdgcn_rcpf(1.0f + __builtin_amdgcn_exp2f(x * -1.4426950408889634f)); }
DI float siluf_(float x) { return x * __builtin_amdgcn_rcpf(1.0f + __builtin_amdgcn_exp2f(x * -1.4426950408889634f)); }
DI float shx(float v, int mask, int lane) { return __builtin_bit_cast(float, __builtin_amdgcn_ds_bpermute((lane ^ mask) << 2, __builtin_bit_cast(int, v))); }
#define DPP_ADD(v, ctrl, rmask) v += __builtin_bit_cast(float, __builtin_amdgcn_update_dpp(0, __builtin_bit_cast(int, v), (ctrl), (rmask), 0xf, false))
DI float wave_sum(float v, int lane) {
    (void)lane;
    DPP_ADD(v, 0xB1, 0xf); DPP_ADD(v, 0x4E, 0xf);
    DPP_ADD(v, 0x141, 0xf); DPP_ADD(v, 0x140, 0xf);
    DPP_ADD(v, 0x142, 0xa); DPP_ADD(v, 0x143, 0xc);
    return __builtin_bit_cast(float, __builtin_amdgcn_readlane(__builtin_bit_cast(int, v), 63));
}
#define DPP_MAX(v, ctrl, rmask) v = __builtin_fmaxf(v, __builtin_bit_cast(float, __builtin_amdgcn_update_dpp(0, __builtin_bit_cast(int, v), (ctrl), (rmask), 0xf, false)))
DI float wave_max_pos(float v) {
    DPP_MAX(v, 0xB1, 0xf); DPP_MAX(v, 0x4E, 0xf); DPP_MAX(v, 0x141, 0xf); DPP_MAX(v, 0x140, 0xf); DPP_MAX(v, 0x142, 0xa); DPP_MAX(v, 0x143, 0xc);
    return __builtin_bit_cast(float, __builtin_amdgcn_readlane(__builtin_bit_cast(int, v), 63));
}
DI unsigned pk4_fp8(float a, float b, float c, float d) { int w = 0; w = __builtin_amdgcn_cvt_pk_fp8_f32(a, b, w, false); w = __builtin_amdgcn_cvt_pk_fp8_f32(c, d, w, true); return (unsigned)w; }
#define LDS_WAIT() asm volatile("s_waitcnt lgkmcnt(0)" ::: "memory")
#define VM_WAIT() asm volatile("s_waitcnt vmcnt(0)" ::: "memory")

constexpr float H8S = 8.0f;
DI unsigned pk4_fp8(float a, float b, float c, float d);
namespace pg8 {
constexpr int BM = 256, BK = 64, HALF = 128, HTB = HALF * BK * 2, STAGE_BYTES = 8 * HTB, NXCD = 8, WGM = 8;
DI int lds_byte(int r, int c) { const int st = (r >> 4) * 2 + (c >> 5), rr = r & 15, cc = c & 31, ob = rr * 64 + cc * 2; return st * 1024 + (ob ^ (((ob >> 9) & 1) << 5)); }
DI void stage_rc(int b, int& R, int& C) { const int st = b / 1024, sb = b % 1024, swz = sb ^ (((sb >> 9) & 1) << 5); R = (st >> 1) * 16 + swz / 64; C = (st & 1) * 32 + (swz % 64) / 2; }
DI int perm32(int rho) { const int n = rho >> 4, i = rho & 15; return 8 * (i >> 2) + 4 * n + (i & 3); }

struct Unit { int pm, pn, e, li; };
struct Gemm { const bf16_t* A; const bf16_t* Bt; int M, N, K; };

struct StaticOrder {
    int nM, nN, nwg, G, c;
    DI void init(int M_, int N_, int G_, int c_) { nM = M_ / BM; nN = N_ / BM; nwg = nM * nN; G = G_; c = c_; }
    DI bool next(int i, Unit& u) const {
        const long L = (long)i * G + c; if (L >= nwg) return false;
        int wgid = (int)L; { const int q = nwg / NXCD, r = nwg % NXCD, xcd = wgid % NXCD, off = wgid / NXCD; wgid = (xcd < r ? xcd * (q + 1) : r * (q + 1) + (xcd - r) * q) + off; }
        const int nig = WGM * nN, gid = wgid / nig, fm = gid * WGM, gsz = (nM - fm) < WGM ? (nM - fm) : WGM;
        u.pm = fm + ((wgid % nig) % gsz); u.pn = (wgid % nig) / gsz; u.e = 0; u.li = 0; return true;
    }
    DI const char* b_tile(const Gemm& g, const Unit& u) const { return (const char*)g.Bt + (size_t)u.pn * ((size_t)BM * g.K * 2); }
    DI unsigned a_rowoff(const Unit&, int) const { return 0u; }
};
struct MoeOrder {
    const LAS int* tab; int G, c; const int* list; int nN, nshift;
    size_t estride;
    int ulo, uhi, n1, mode;
    unsigned* rdy;
    DI void range(int lo, int hi, int n1_, int mode_) { ulo = lo; uhi = hi < lo ? lo : hi; n1 = n1_; mode = mode_; }
    DI bool next(int i, Unit& u) const {
        int L;
        if (mode == 0 || n1 >= G) L = ulo + i * G + c;
        else if (c < n1) return false;
        else L = ulo + i * (G - n1) + (c - n1);
        if (L >= uhi) return false;
        const int rt = L >> nshift; u.pn = L & (nN - 1); u.pm = rt; int e = 0;
#pragma unroll
        for (int j = 1; j < 16; ++j) e += (rt >= tab[j]) ? 1 : 0;
        u.e = e; u.li = rt - tab[e];
        if (rdy) {
            unsigned sp = 0;
            while (__hip_atomic_load(rdy + rt, __ATOMIC_RELAXED, __HIP_MEMORY_SCOPE_AGENT) < (unsigned)nN) { __builtin_amdgcn_s_sleep(1); if (++sp > (1u << 22)) break; }
            asm volatile("" ::: "memory");
        }
        return true;
    }
    DI const char* b_tile(const Gemm& g, const Unit& u) const { return (const char*)g.Bt + (size_t)u.e * estride + (size_t)u.pn * ((size_t)BM * g.K * 2); }
    unsigned apitch;
    DI unsigned a_rowoff(const Unit& u, int r) const { const int idx = u.li * 256 + r; const int tok = (idx < tab[32 + u.e]) ? list[u.e * M + idx] : 0; return (unsigned)tok * apitch; }
};
struct SkipOrder : StaticOrder {
    DI void init2(int M_, int N_, int G_, int c_, int skip) { if (skip >= G_) skip = 0; StaticOrder::init(M_, N_, G_ - skip, c_ - skip); neg = (c_ < skip); }
    bool neg;
    DI bool next(int i, Unit& u) const { if (neg) return false; return StaticOrder::next(i, u); }
};

typedef f32x4 Acc[2][2][4][2];

DI f32x2 gelu_pk(f32x2 v) {
    const f32x2 av = __builtin_elementwise_abs(v), d = av * 0.2316418882f + 1.0f;
    f32x2 t; t.x = __builtin_amdgcn_rcpf(d.x); t.y = __builtin_amdgcn_rcpf(d.y);
    f32x2 q = t * 0.5307027145f + (-0.7265760135f); q = q * t + 0.7107068705f; q = q * t + (-0.142248368f); q = q * t + 0.127414796f; q = q * t;
    const f32x2 s = (v * v) * (-0.72134752044f);
    f32x2 e; e.x = __builtin_amdgcn_exp2f(s.x); e.y = __builtin_amdgcn_exp2f(s.y);
    const f32x2 m = v * (q * e), r = v - m;
    f32x2 o; o.x = v.x < 0.f ? m.x : r.x; o.y = v.y < 0.f ? m.y : r.y; return o;
}
DI f32x4 gelu4(f32x4 v) { const f32x2 a = gelu_pk((f32x2){v[0], v[1]}), b = gelu_pk((f32x2){v[2], v[3]}); return (f32x4){a.x, a.y, b.x, b.y}; }

DI u32x4 rowmajor16(u32x4 w, int fr, int fq) {
    const int l = fq * 16 + fr, src = (16 * (l & 3) + (l >> 2)) << 2; u32x4 o;
    o.x = (unsigned)__builtin_amdgcn_ds_bpermute(src, (int)w.x); o.y = (unsigned)__builtin_amdgcn_ds_bpermute(src, (int)w.y);
    o.z = (unsigned)__builtin_amdgcn_ds_bpermute(src, (int)w.z); o.w = (unsigned)__builtin_amdgcn_ds_bpermute(src, (int)w.w); return o;
}
DI u32x2 rowmajor8(u32x2 w, int fr, int fq) {
    const int l = fq * 16 + fr, src = (16 * (l & 3) + (l >> 2)) << 2; u32x2 o;
    o.x = (unsigned)__builtin_amdgcn_ds_bpermute(src, (int)w.x); o.y = (unsigned)__builtin_amdgcn_ds_bpermute(src, (int)w.y); return o;
}
template <bool PERMK>
DI void tgroup_lds(LAS unsigned char* xlds, const u32x4 w0, const u32x4 w1, int fr, int fq, u32x4 (&out)[2]) {
    const unsigned a0[4] = {w0.x, w0.y, w0.z, w0.w}, a1[4] = {w1.x, w1.y, w1.z, w1.w};
#pragma unroll
    for (int j = 0; j < 8; ++j) {
        const int lf = 8 * fq + j, lr = PERMK ? (16 * ((j >> 2) & 1) + 4 * fq + (j & 3)) : lf;
        const unsigned short v0 = (unsigned short)((j & 1) ? (a0[j >> 1] >> 16) : (a0[j >> 1] & 0xffffu)), v1 = (unsigned short)((j & 1) ? (a1[j >> 1] >> 16) : (a1[j >> 1] & 0xffffu));
        *(LAS unsigned short*)(xlds + lr * 48 + fr * 2) = v0; *(LAS unsigned short*)(xlds + (32 + lr) * 48 + fr * 2) = v1;
    }
    LDS_WAIT(); asm volatile("" ::: "memory");
    const int lane = fq * 16 + fr;
    out[0] = *(const LAS u32x4*)(xlds + lane * 48); out[1] = *(const LAS u32x4*)(xlds + lane * 48 + 16);
    LDS_WAIT(); asm volatile("" ::: "memory");
}
struct EpiAin {
    static constexpr bool PERM = true;
    bf16_t* BG; bf16_t* Z;
    DI void operator()(const Acc& acc, const Unit& u, int wr, int wc, int fr, int fq) const {
        const int l = fq * 16 + fr, pfr = l >> 2, pfq = l & 3;
        const int row0 = u.pm * BM + wr * 64 + pfr, cw = wc * 32 + 8 * pfq;
        if (u.pn < 4) {
#pragma unroll
            for (int ai = 0; ai < 2; ++ai)
#pragma unroll
                for (int m = 0; m < 4; ++m) { bf16_t* rowp = BG + (size_t)(row0 + ai * HALF + m * 16) * D + u.pn * 256 + cw;
#pragma unroll
                    for (int bj = 0; bj < 2; ++bj) *(u32x4*)(rowp + bj * HALF) = rowmajor16(pk8(acc[ai][bj][m][0], acc[ai][bj][m][1]), fr, fq); }
        } else {
#pragma unroll
            for (int ai = 0; ai < 2; ++ai)
#pragma unroll
                for (int m = 0; m < 4; ++m) { bf16_t* rowp = Z + (size_t)(row0 + ai * HALF + m * 16) * D + (u.pn - 4) * 128 + cw;
                    *(u32x4*)rowp = rowmajor16(pk8(acc[ai][0][m][0] * acc[ai][1][m][0], acc[ai][0][m][1] * acc[ai][1][m][1]), fr, fq); }
        }
    }
};
struct EpiS1 {
    static constexpr bool PERM = true;
    const bf16_t* X; bf16_t* S1;
    DI void operator()(const Acc& acc, const Unit& u, int wr, int wc, int fr, int fq) const {
        const int row0 = u.pm * BM + wr * 64 + fr, cw = u.pn * 256 + wc * 32 + 8 * fq;
        u32x4 xr[2][4][2];
#pragma unroll
        for (int ai = 0; ai < 2; ++ai)
#pragma unroll
            for (int m = 0; m < 4; ++m)
#pragma unroll
                for (int bj = 0; bj < 2; ++bj) xr[ai][m][bj] = *(const u32x4*)(X + (size_t)(row0 + ai * HALF + m * 16) * D + cw + bj * HALF);
#pragma unroll
        for (int ai = 0; ai < 2; ++ai)
#pragma unroll
            for (int m = 0; m < 4; ++m) { const size_t off = (size_t)(row0 + ai * HALF + m * 16) * D + cw;
#pragma unroll
                for (int bj = 0; bj < 2; ++bj) { f32x4 x0, x1; unpk8(xr[ai][m][bj], x0, x1);
                    *(u32x4*)(S1 + off + bj * HALF) = pk8(x0 * ALPHA + acc[ai][bj][m][0], x1 * ALPHA + acc[ai][bj][m][1]); } }
    }
};
struct EpiBin {
    static constexpr bool PERM = true;
    bf16_t *QP, *KP, *KT, *VT, *GS; const float *COS, *SIN; LAS unsigned char* xbase;
    DI void operator()(const Acc& acc, const Unit& u, int wr, int wc, int fr, int fq) const {
        const int row0 = u.pm * BM + wr * 64 + fr, cw = wc * 32 + 8 * fq, pn = u.pn; LAS unsigned char* xlds = xbase + (wr * 4 + wc) * 3072;
        u32x4 tv[4][2], kw[4][2];
        if (pn < 8) {
            const bool isk = pn >= 4; const int h = pn & 3;
            const float lg2 = __log2f(1.0f - __builtin_amdgcn_exp2f(-5.0f - (float)h));
            bf16_t* dst = isk ? KP : QP;
#pragma unroll
            for (int ai = 0; ai < 2; ++ai) {
                f32x4 csn[4][4];
#pragma unroll
                for (int m = 0; m < 4; ++m) { const int pos_ = (row0 + ai * HALF + m * 16) & (SEQ - 1);
                    csn[m][0] = *(const f32x4*)(COS + (size_t)pos_ * 128 + cw); csn[m][1] = *(const f32x4*)(COS + (size_t)pos_ * 128 + cw + 4);
                    csn[m][2] = *(const f32x4*)(SIN + (size_t)pos_ * 128 + cw); csn[m][3] = *(const f32x4*)(SIN + (size_t)pos_ * 128 + cw + 4); }
#pragma unroll
                for (int m = 0; m < 4; ++m) {
                    const int row = row0 + ai * HALF + m * 16, c = row & (CH - 1);
                    const float scale = isk ? __builtin_amdgcn_exp2f(-(float)c * lg2) * 0.0625f : __builtin_amdgcn_exp2f((float)c * lg2);
                    const f32x4 cs0 = csn[m][0], cs1 = csn[m][1], sn0 = csn[m][2], sn1 = csn[m][3];
                    const f32x4 a0 = acc[ai][0][m][0], a1 = acc[ai][0][m][1], b0 = acc[ai][1][m][0], b1 = acc[ai][1][m][1];
                    const f32x4 o10 = (a0 * cs0 - b0 * sn0) * scale, o11 = (a1 * cs1 - b1 * sn1) * scale;
                    const f32x4 o20 = (b0 * cs0 + a0 * sn0) * scale, o21 = (b1 * cs1 + a1 * sn1) * scale;
                    const u32x4 w1 = pk8(o10, o11), w2 = pk8(o20, o21);
                    if (!isk) { *(u32x4*)(dst + tl16((size_t)row, h * 256 + cw, D)) = w1; *(u32x4*)(dst + tl16((size_t)row, h * 256 + 128 + cw, D)) = w2; }
                    else { kw[m][0] = w1; kw[m][1] = w2; tgroup_lds<true>(xlds, w1, w2, fr, fq, tv[m]); }
                }
              if (isk) {
                const int ln = fq * 16 + fr, er = h * 256 + (ln < 32 ? 0 : 128) + wc * 32 + (ln & 31);
#pragma unroll
                for (int m = 0; m < 4; ++m) { const size_t srow = (size_t)sig32(row0 + ai * HALF + m * 16);
                    *(u32x4*)(dst + tl16(srow, h * 256 + cw, D)) = kw[m][0]; *(u32x4*)(dst + tl16(srow, h * 256 + 128 + cw, D)) = kw[m][1]; }
#pragma unroll
                for (int m = 0; m < 4; ++m) { const int rowg = u.pm * BM + wr * 64 + ai * HALF + m * 16;
#pragma unroll
                    for (int hh = 0; hh < 2; ++hh) *(u32x4*)(KT + tl16t((size_t)(rowg >> 7), D, er, (rowg & (CH - 1)) + 8 * hh)) = tv[m][hh]; }
              }
            }
        } else if (pn < 16) {
#pragma unroll
            for (int ai = 0; ai < 2; ++ai) {
#pragma unroll
                for (int m = 0; m < 4; ++m) tgroup_lds<false>(xlds, pk8(acc[ai][0][m][0], acc[ai][0][m][1]), pk8(acc[ai][1][m][0], acc[ai][1][m][1]), fr, fq, tv[m]);
                const int ln = fq * 16 + fr, er = (pn - 8) * 256 + (ln < 32 ? 0 : HALF) + wc * 32 + (ln & 31);
#pragma unroll
                for (int m = 0; m < 4; ++m) { const int rowg = u.pm * BM + wr * 64 + ai * HALF + m * 16;
#pragma unroll
                    for (int hh = 0; hh < 2; ++hh) *(u32x4*)(VT + tl16t((size_t)(rowg >> 7), VD, er, (rowg & (CH - 1)) + 8 * hh)) = tv[m][hh]; }
            }
        } else {
#pragma unroll
            for (int ai = 0; ai < 2; ++ai)
#pragma unroll
                for (int m = 0; m < 4; ++m) { bf16_t* rowp = GS + (size_t)(row0 + ai * HALF + m * 16) * VD + (pn - 16) * 256 + cw;
#pragma unroll
                    for (int bj = 0; bj < 2; ++bj) { f32x4 v0 = acc[ai][bj][m][0], v1 = acc[ai][bj][m][1];
#pragma unroll
                        for (int j = 0; j < 4; ++j) { v0[j] = siluf_(v0[j]); v1[j] = siluf_(v1[j]); }
                        *(u32x4*)(rowp + bj * HALF) = pk8(v0, v1); } }
        }
    }
};
struct EpiCin {
    static constexpr bool PERM = true;
    bf16_t *U, *VT; f32x2* ST; LAS unsigned char* xbase;
    DI void operator()(const Acc& acc, const Unit& u, int wr, int wc, int fr, int fq) const {
        const int row0 = u.pm * BM + wr * 64 + fr, cw = wc * 32 + 8 * fq, pn = u.pn; LAS unsigned char* xlds = xbase + (wr * 4 + wc) * 3072; u32x4 tv[4][2]; f32x2 stv = {0.f, 0.f};
        if (pn < 12) {
#pragma unroll
            for (int ai = 0; ai < 2; ++ai)
#pragma unroll
                for (int m = 0; m < 4; ++m) { bf16_t* rowp = U + (size_t)(row0 + ai * HALF + m * 16) * SH + pn * 256 + cw;
#pragma unroll
                    for (int bj = 0; bj < 2; ++bj) *(u32x4*)(rowp + bj * HALF) = pk8(gelu4(acc[ai][bj][m][0]), gelu4(acc[ai][bj][m][1])); }
        } else {
#pragma unroll
            for (int ai = 0; ai < 2; ++ai) {
#pragma unroll
                for (int m = 0; m < 4; ++m) {
                    const int row = row0 + ai * HALF + m * 16; float s = 0.f, ss = 0.f;
                    u32x4 wv2[2];
#pragma unroll
                    for (int bj = 0; bj < 2; ++bj) {
                        const u32x4 w = pk8(gelu4(acc[ai][bj][m][0]), gelu4(acc[ai][bj][m][1])); const unsigned ww[4] = {w.x, w.y, w.z, w.w}; wv2[bj] = w;
#pragma unroll
                        for (int j = 0; j < 4; ++j) { const float lo = bf_lo(ww[j]), hi = bf_hi(ww[j]); s += lo + hi; ss += lo * lo + hi * hi; }
                    }
                    tgroup_lds<false>(xlds, wv2[0], wv2[1], fr, fq, tv[m]);
                    { const int ln = fq * 16 + fr; s += shx(s, 16, ln); s += shx(s, 32, ln); ss += shx(ss, 16, ln); ss += shx(ss, 32, ln); }
                    if (fq == m) stv = (f32x2){s, ss};
                }
                ST[(size_t)(row0 + ai * HALF + fq * 16) * 48 + (pn - 12) * 4 + wc] = stv;
                const int ln = fq * 16 + fr, er = (pn - 12) * 256 + (ln < 32 ? 0 : HALF) + wc * 32 + (ln & 31);
#pragma unroll
                for (int m = 0; m < 4; ++m) { const int rowg = u.pm * BM + wr * 64 + ai * HALF + m * 16;
#pragma unroll
                    for (int hh = 0; hh < 2; ++hh) *(u32x4*)(VT + tl16t((size_t)(rowg >> 7), SH, er, (rowg & (CH - 1)) + 8 * hh)) = tv[m][hh]; }
            }
        }
    }
};
struct EpiMoe1 {
    static constexpr bool PERM = true;
    static constexpr bool SIGNAL = true;
    bf16_t* H; unsigned* rdy; unsigned* agg; unsigned x, nloc; const float* RSC; const float* CSC; const LAS int* tabp;
    DI void operator()(const Acc& acc, const Unit& u, int wr, int wc, int fr, int fq) const {
        const int l = fq * 16 + fr, pfr = l >> 2, pfq = l & 3;
        const int row0 = u.pm * BM + wr * 64 + pfr, cw = u.pn * 128 + wc * 32 + 8 * pfq;
#pragma unroll
        for (int ai = 0; ai < 2; ++ai)
#pragma unroll
            for (int m = 0; m < 4; ++m) { f32x4 v0 = acc[ai][0][m][0], v1 = acc[ai][0][m][1], u0 = acc[ai][1][m][0], u1 = acc[ai][1][m][1];
                if (RSC) { const int idx = u.li * 256 + wr * 64 + ai * HALF + m * 16 + fr; const float xs = idx < tabp[32 + u.e] ? RSC[(size_t)u.e * M + idx] : 0.f;
                    const float* cg = CSC + (size_t)u.e * 1024 + u.pn * 256 + wc * 32 + 8 * fq;
                    v0 *= *(const f32x4*)cg * xs; v1 *= *(const f32x4*)(cg + 4) * xs; u0 *= *(const f32x4*)(cg + 128) * xs; u1 *= *(const f32x4*)(cg + 132) * xs; }
#pragma unroll
                for (int j = 0; j < 4; ++j) { v0[j] = siluf_(v0[j]) * u0[j]; v1[j] = siluf_(v1[j]) * u1[j]; }
                if (RSC) { u32x2 q; q.x = pk4_fp8(v0[0] * H8S, v0[1] * H8S, v0[2] * H8S, v0[3] * H8S); q.y = pk4_fp8(v1[0] * H8S, v1[1] * H8S, v1[2] * H8S, v1[3] * H8S);
                    *(u32x2*)((unsigned char*)H + (size_t)(row0 + ai * HALF + m * 16) * DE + cw) = rowmajor8(q, fr, fq); }
                else *(u32x4*)(H + (size_t)(row0 + ai * HALF + m * 16) * DE + cw) = rowmajor16(pk8(v0, v1), fr, fq); }
    }
};
struct EpiPlain {
    static constexpr bool PERM = true;
    bf16_t* O; int ld; const float* CS; float sc;
    DI void operator()(const Acc& acc, const Unit& u, int wr, int wc, int fr, int fq) const {
        const int l = fq * 16 + fr, pfr = l >> 2, pfq = l & 3;
        const int row0 = u.pm * BM + wr * 64 + pfr, cw = u.pn * 256 + wc * 32 + 8 * pfq;
        f32x4 cs[2][2];
#pragma unroll
        for (int bj = 0; bj < 2; ++bj) { const float* cp = CS ? CS + (size_t)u.e * 1024 + u.pn * 256 + bj * HALF + wc * 32 + 8 * fq : nullptr;
            cs[bj][0] = CS ? *(const f32x4*)cp * sc : (f32x4){1.f, 1.f, 1.f, 1.f}; cs[bj][1] = CS ? *(const f32x4*)(cp + 4) * sc : (f32x4){1.f, 1.f, 1.f, 1.f}; }
#pragma unroll
        for (int ai = 0; ai < 2; ++ai)
#pragma unroll
            for (int m = 0; m < 4; ++m) { bf16_t* rowp = O + (size_t)(row0 + ai * HALF + m * 16) * ld + cw;
#pragma unroll
                for (int bj = 0; bj < 2; ++bj) *(u32x4*)(rowp + bj * HALF) = rowmajor16(pk8(acc[ai][bj][m][0] * cs[bj][0], acc[ai][bj][m][1] * cs[bj][1]), fr, fq); }
    }
};
struct EpiPle {
    static constexpr bool PERM = true;
    const bf16_t* X2; const bf16_t* EMB; const float* bias; bf16_t* XN; float* OUT; int last; const float* XS; const float* CS;
    DI void operator()(const Acc& acc, const Unit& u, int wr, int wc, int fr, int fq) const {
        const int row0 = u.pm * BM + wr * 64 + fr, cw = u.pn * 256 + wc * 32 + 8 * fq;
#pragma unroll
        for (int ai = 0; ai < 2; ++ai) {
            u32x4 xr[4][2], er[4][2]; float xs[4];
#pragma unroll
            for (int m = 0; m < 4; ++m) xs[m] = XS[row0 + ai * HALF + m * 16];
#pragma unroll
            for (int m = 0; m < 4; ++m)
#pragma unroll
                for (int bj = 0; bj < 2; ++bj) { const size_t o2 = (size_t)(row0 + ai * HALF + m * 16) * D + cw + bj * HALF; xr[m][bj] = *(const u32x4*)(X2 + o2); er[m][bj] = *(const u32x4*)(EMB + o2); }
#pragma unroll
            for (int bj = 0; bj < 2; ++bj) {
                const f32x4 b0 = *(const f32x4*)(bias + cw + bj * HALF), b1 = *(const f32x4*)(bias + cw + bj * HALF + 4);
                const f32x4 c0 = *(const f32x4*)(CS + cw + bj * HALF), c1 = *(const f32x4*)(CS + cw + bj * HALF + 4);
#pragma unroll
                for (int m = 0; m < 4; ++m) { const size_t off = (size_t)(row0 + ai * HALF + m * 16) * D + cw;
                    f32x4 x0, x1, e0, e1; unpk8(xr[m][bj], x0, x1); unpk8(er[m][bj], e0, e1);
                    f32x4 g0 = acc[ai][bj][m][0] * (c0 * xs[m]) + b0, g1 = acc[ai][bj][m][1] * (c1 * xs[m]) + b1;
#pragma unroll
                    for (int j = 0; j < 4; ++j) { g0[j] = x0[j] + sigmoidf_(g0[j]) * e0[j]; g1[j] = x1[j] + sigmoidf_(g1[j]) * e1[j]; }
                    if (last) { *(f32x4*)(OUT + off + bj * HALF) = g0; *(f32x4*)(OUT + off + bj * HALF + 4) = g1; }
                    else *(u32x4*)(XN + off + bj * HALF) = pk8(g0, g1);
                } }
        }
    }
};


template <class E, class = void> struct epi_signal { static constexpr bool value = false; };
template <class E> struct epi_signal<E, decltype((void)E::SIGNAL)> { static constexpr bool value = E::SIGNAL; };
typedef int i32x8 __attribute__((ext_vector_type(8)));
typedef int i32x4v __attribute__((ext_vector_type(4)));
template <class Epi, class Sched, bool GATHER, bool F8 = false>
DI void gemm_phase(LAS unsigned char* lds, const Gemm g, const Sched& S, const Epi& E, const int tid) {
    const int wid = __builtin_amdgcn_readfirstlane(tid >> 6), lane = tid & 63, wr = wid >> 2, wc = wid & 3, fr = lane & 15, fq = lane >> 4;
    int Kl = g.K; asm volatile("" : "+s"(Kl));
    const int K = Kl, nt = K / BK;
    unsigned voffA[2], voffB[2]; int RA[2], CA[2];
#pragma unroll
    for (int i = 0; i < 2; ++i) { int R, C; stage_rc(tid * 16 + i * 8192, R, C); const int Rb = Epi::PERM ? ((R & ~31) + perm32(R & 31)) : R;
        RA[i] = R; CA[i] = C; voffA[i] = (unsigned)(R * K + C) * 2u; voffB[i] = (unsigned)(Rb * K + C) * 2u; }
    const size_t kstep = (size_t)(BK * 2);
    const size_t hstep = (size_t)HALF * K * 2;
    const size_t tstep = 2 * hstep;
    const unsigned ldsw = (unsigned)wid * 1024u;
    const int aoff = lds_byte(wr * 64 + fr, fq * 8), boff = lds_byte(wc * 32 + fr, fq * 8);
#define PG8_SA(b, h) (((b) * 2 + (h)) * HTB)
#define PG8_SB(b, h) ((4 + (b) * 2 + (h)) * HTB)
#define PG8_STAGE(bufoff, gbase, voff) do { _Pragma("unroll") for (int _i = 0; _i < 2; ++_i) \
        __builtin_amdgcn_global_load_lds((const unsigned*)((const char*)(gbase) + (voff)[_i]), (LAS unsigned*)(lds + (bufoff) + ldsw + _i * 8192), 16, 0, 0); } while (0)
#define PG8_CAT8(p) __builtin_shufflevector(*(const LAS i32x4v*)(p), *(const LAS i32x4v*)((p) + 1024), 0, 1, 2, 3, 4, 5, 6, 7)
#define PG8_LDA(dst, b, h) do { _Pragma("unroll") for (int m = 0; m < 4; ++m) { if constexpr (F8) dst##8[m] = PG8_CAT8(lds + PG8_SA(b, h) + aoff + m * 2048); \
        else { _Pragma("unroll") for (int k = 0; k < 2; ++k) dst[m][k] = *(const LAS bf16x8*)(lds + PG8_SA(b, h) + aoff + m * 2048 + k * 1024); } } } while (0)
#define PG8_LDB(dst, b, h) do { _Pragma("unroll") for (int n = 0; n < 2; ++n) { if constexpr (F8) dst##8[n] = PG8_CAT8(lds + PG8_SB(b, h) + boff + n * 2048); \
        else { _Pragma("unroll") for (int k = 0; k < 2; ++k) dst[n][k] = *(const LAS bf16x8*)(lds + PG8_SB(b, h) + boff + n * 2048 + k * 1024); } } } while (0)
#define PG8_MMA(ai, bj, At, Bt) do { __builtin_amdgcn_s_setprio(1); _Pragma("unroll") for (int m = 0; m < 4; ++m) _Pragma("unroll") for (int n = 0; n < 2; ++n) { \
        if constexpr (F8) asm volatile("v_mfma_f32_16x16x128_f8f6f4 %0, %1, %2, %0" : "+v"(acc[ai][bj][m][n]) : "v"(Bt##8[n]), "v"(At##8[m]));        \
        else { _Pragma("unroll") for (int k = 0; k < 2; ++k) acc[ai][bj][m][n] = __builtin_amdgcn_mfma_f32_16x16x32_bf16(Bt[n][k], At[m][k], acc[ai][bj][m][n], 0, 0, 0); } } \
        __builtin_amdgcn_s_setprio(0); } while (0)
#define PG8_WAIT_V(n) asm volatile("s_waitcnt vmcnt(" #n ")" ::: "memory")
#define PG8_WAIT_L(n) asm volatile("s_waitcnt lgkmcnt(" #n ")" ::: "memory")
#define PG8_BAR __builtin_amdgcn_s_barrier()
#define PG8_SCHED __builtin_amdgcn_sched_barrier(0)
    Unit cur, nxt; int ui = 0, pend = -1; bool arrived = false; (void)pend; (void)arrived;
    if (!S.next(0, cur)) {
        if constexpr (epi_signal<Epi>::value) {
            if (wid == 0 && E.nloc != 0u) {
                unsigned last = 0u;
                if (lane == 0) { const unsigned old = __hip_atomic_fetch_add(E.agg + E.x * 16, 1u, __ATOMIC_RELAXED, __HIP_MEMORY_SCOPE_AGENT); last = (old + 1u == E.nloc) ? 1u : 0u; }
                last = (unsigned)__builtin_amdgcn_readfirstlane((int)last);
                if (last) {
                    __builtin_amdgcn_fence(__ATOMIC_RELEASE, "agent"); asm volatile("s_waitcnt vmcnt(0)" ::: "memory");
                    for (int i = lane; i < S.G; i += 64) {
                        const unsigned p = __hip_atomic_load(E.agg + 256 + i, __ATOMIC_RELAXED, __HIP_MEMORY_SCOPE_AGENT);
                        if ((p >> 24) == E.x + 1u) { (void)__hip_atomic_fetch_add(E.rdy + (p & 0xfffu) - 1u, 1u, __ATOMIC_RELAXED, __HIP_MEMORY_SCOPE_AGENT);
                            if ((p >> 12) & 0xfffu) (void)__hip_atomic_fetch_add(E.rdy + ((p >> 12) & 0xfffu) - 1u, 1u, __ATOMIC_RELAXED, __HIP_MEMORY_SCOPE_AGENT); }
                    }
                }
            }
        }
        return;
    }
    Acc acc;
#pragma unroll
    for (int a = 0; a < 2; ++a)
#pragma unroll
        for (int b = 0; b < 2; ++b)
#pragma unroll
            for (int m = 0; m < 4; ++m)
#pragma unroll
                for (int n = 0; n < 2; ++n) acc[a][b][m][n] = (f32x4){0.f, 0.f, 0.f, 0.f};
    bf16x8 At[4][2], B0[2][2], B1[2][2]; i32x8 At8[4], B08[2], B18[2]; (void)At; (void)B0; (void)B1; (void)At8; (void)B08; (void)B18;
    const char* cA = (const char*)g.A + (GATHER ? (size_t)0 : (size_t)cur.pm * tstep); const char* cB = S.b_tile(g, cur);
    unsigned gC[2][2], gN[2][2];
    if constexpr (GATHER) {
#pragma unroll
        for (int h = 0; h < 2; ++h)
#pragma unroll
            for (int i = 0; i < 2; ++i) { gC[h][i] = S.a_rowoff(cur, h * HALF + RA[i]) + (unsigned)CA[i] * 2u; gN[h][i] = gC[h][i]; }
    }
    if constexpr (GATHER) {
        PG8_STAGE(PG8_SB(0, 0), cB, voffB); PG8_STAGE(PG8_SB(0, 1), cB + hstep, voffB); PG8_STAGE(PG8_SA(0, 0), cA, gC[0]); PG8_STAGE(PG8_SA(0, 1), cA, gC[1]);
        if (wr == 1) PG8_BAR;
        PG8_WAIT_V(2); PG8_BAR;
        PG8_STAGE(PG8_SB(1, 0), cB + kstep, voffB); PG8_STAGE(PG8_SA(1, 0), cA + kstep, gC[0]); PG8_STAGE(PG8_SB(1, 1), cB + hstep + kstep, voffB);
        PG8_WAIT_V(6); PG8_BAR;
    } else {
        PG8_STAGE(PG8_SB(0, 0), cB, voffB); PG8_STAGE(PG8_SB(0, 1), cB + hstep, voffB); PG8_STAGE(PG8_SA(0, 0), cA, voffA); PG8_STAGE(PG8_SA(0, 1), cA + hstep, voffA);
        if (wr == 1) PG8_BAR;
        PG8_WAIT_V(2); PG8_BAR;
        PG8_STAGE(PG8_SB(1, 0), cB + kstep, voffB); PG8_STAGE(PG8_SA(1, 0), cA + kstep, voffA); PG8_STAGE(PG8_SB(1, 1), cB + hstep + kstep, voffB);
        PG8_WAIT_V(6); PG8_BAR;
    }
    for (;;) {
        const bool has_next = S.next(ui + 1, nxt);
        const char* nA = (has_next && !GATHER) ? (const char*)g.A + (size_t)nxt.pm * tstep : cA; const char* nB = has_next ? S.b_tile(g, nxt) : cB;
        if constexpr (GATHER) {
            if (has_next) {
#pragma unroll
                for (int h = 0; h < 2; ++h)
#pragma unroll
                    for (int i = 0; i < 2; ++i) gN[h][i] = S.a_rowoff(nxt, h * HALF + RA[i]) + (unsigned)CA[i] * 2u;
            }
        }
        for (int t = 0; t < nt; t += 2) {
            const bool last = (t == nt - 2);
            const char* a1 = cA + (size_t)(t + 1) * kstep;
            const char* a2 = last ? nA : cA + (size_t)(t + 2) * kstep; const char* b2 = last ? nB : cB + (size_t)(t + 2) * kstep;
            const char* a3 = a2 + kstep; const char* b3 = b2 + kstep;
            if constexpr (GATHER) {
                unsigned g2[2][2];
#pragma unroll
                for (int h = 0; h < 2; ++h)
#pragma unroll
                    for (int i = 0; i < 2; ++i) g2[h][i] = last ? gN[h][i] : gC[h][i];
                PG8_LDB(B0, 0, 0); PG8_LDB(B1, 0, 1); PG8_SCHED; PG8_LDA(At, 0, 0); PG8_STAGE(PG8_SA(1, 1), a1, gC[1]);
                PG8_WAIT_V(8); PG8_WAIT_L(0); PG8_BAR; PG8_MMA(0, 0, At, B0); PG8_MMA(0, 1, At, B1); PG8_BAR; PG8_SCHED;
                PG8_LDA(At, 0, 1); PG8_STAGE(PG8_SB(0, 0), b2, voffB); PG8_STAGE(PG8_SB(0, 1), b2 + hstep, voffB); PG8_STAGE(PG8_SA(0, 0), a2, g2[0]);
                PG8_WAIT_V(8); PG8_WAIT_L(0); PG8_BAR; PG8_MMA(1, 0, At, B0); PG8_MMA(1, 1, At, B1); PG8_BAR; PG8_SCHED;
                PG8_LDB(B0, 1, 0); PG8_LDB(B1, 1, 1); PG8_SCHED; PG8_LDA(At, 1, 0); PG8_STAGE(PG8_SA(0, 1), a2, g2[1]);
                PG8_WAIT_V(8); PG8_WAIT_L(0); PG8_BAR; PG8_MMA(0, 0, At, B0); PG8_MMA(0, 1, At, B1); PG8_BAR; PG8_SCHED;
                PG8_LDA(At, 1, 1); PG8_STAGE(PG8_SB(1, 0), b3, voffB); PG8_STAGE(PG8_SB(1, 1), b3 + hstep, voffB); PG8_STAGE(PG8_SA(1, 0), a3, g2[0]);
                PG8_WAIT_V(8); PG8_WAIT_L(0); PG8_BAR; PG8_MMA(1, 0, At, B0); PG8_MMA(1, 1, At, B1); PG8_BAR; PG8_SCHED;
            } else {
                PG8_LDB(B0, 0, 0); PG8_LDB(B1, 0, 1); PG8_SCHED; PG8_LDA(At, 0, 0); PG8_STAGE(PG8_SA(1, 1), a1 + hstep, voffA);
                PG8_WAIT_V(8); PG8_WAIT_L(0); PG8_BAR; PG8_MMA(0, 0, At, B0); PG8_MMA(0, 1, At, B1); PG8_BAR; PG8_SCHED;
                PG8_LDA(At, 0, 1); PG8_STAGE(PG8_SB(0, 0), b2, voffB); PG8_STAGE(PG8_SB(0, 1), b2 + hstep, voffB); PG8_STAGE(PG8_SA(0, 0), a2, voffA);
                PG8_WAIT_V(8); PG8_WAIT_L(0); PG8_BAR; PG8_MMA(1, 0, At, B0); PG8_MMA(1, 1, At, B1); PG8_BAR; PG8_SCHED;
                PG8_LDB(B0, 1, 0); PG8_LDB(B1, 1, 1); PG8_SCHED; PG8_LDA(At, 1, 0); PG8_STAGE(PG8_SA(0, 1), a2 + hstep, voffA);
                PG8_WAIT_V(8); PG8_WAIT_L(0); PG8_BAR; PG8_MMA(0, 0, At, B0); PG8_MMA(0, 1, At, B1); PG8_BAR; PG8_SCHED;
                PG8_LDA(At, 1, 1); PG8_STAGE(PG8_SB(1, 0), b3, voffB); PG8_STAGE(PG8_SB(1, 1), b3 + hstep, voffB); PG8_STAGE(PG8_SA(1, 0), a3, voffA);
                PG8_WAIT_V(8); PG8_WAIT_L(0); PG8_BAR; PG8_MMA(1, 0, At, B0); PG8_MMA(1, 1, At, B1); PG8_BAR; PG8_SCHED;
            }
        }
        if (wr == 0) PG8_BAR;
        E(acc, cur, wr, wc, fr, fq);
        if constexpr (epi_signal<Epi>::value) {
            if (ui == 0 && has_next) pend = cur.pm;
            else {
                PG8_WAIT_V(0); PG8_BAR;
                if (wid == 0) {
                    const unsigned pay = (unsigned)(cur.pm + 1) | ((unsigned)(pend + 1) << 12) | ((E.x + 1u) << 24);
                    if (!arrived && E.nloc != 0u) {
                        unsigned last = 0u;
                        if (lane == 0) {
                            __hip_atomic_store(E.agg + 256 + S.c, pay, __ATOMIC_RELAXED, __HIP_MEMORY_SCOPE_AGENT); asm volatile("s_waitcnt vmcnt(0)" ::: "memory");
                            const unsigned old = __hip_atomic_fetch_add(E.agg + E.x * 16, 1u, __ATOMIC_RELAXED, __HIP_MEMORY_SCOPE_AGENT);
                            last = (old + 1u == E.nloc) ? 1u : 0u;
                        }
                        last = (unsigned)__builtin_amdgcn_readfirstlane((int)last);
                        if (last) {
                            __builtin_amdgcn_fence(__ATOMIC_RELEASE, "agent"); asm volatile("s_waitcnt vmcnt(0)" ::: "memory");
                            for (int i = lane; i < S.G; i += 64) {
                                const unsigned p = __hip_atomic_load(E.agg + 256 + i, __ATOMIC_RELAXED, __HIP_MEMORY_SCOPE_AGENT);
                                if ((p >> 24) == E.x + 1u) { (void)__hip_atomic_fetch_add(E.rdy + (p & 0xfffu) - 1u, 1u, __ATOMIC_RELAXED, __HIP_MEMORY_SCOPE_AGENT);
                                    if ((p >> 12) & 0xfffu) (void)__hip_atomic_fetch_add(E.rdy + ((p >> 12) & 0xfffu) - 1u, 1u, __ATOMIC_RELAXED, __HIP_MEMORY_SCOPE_AGENT); }
                            }
                        }
                    } else if (lane == 0) {
                        __builtin_amdgcn_fence(__ATOMIC_RELEASE, "agent"); asm volatile("s_waitcnt vmcnt(0)" ::: "memory"); (void)__hip_atomic_fetch_add(E.rdy + cur.pm, 1u, __ATOMIC_RELAXED, __HIP_MEMORY_SCOPE_AGENT);
                        if (pend >= 0) (void)__hip_atomic_fetch_add(E.rdy + pend, 1u, __ATOMIC_RELAXED, __HIP_MEMORY_SCOPE_AGENT);
                    }
                }
                arrived = true; pend = -1;
            }
        }
        if (!has_next) break;
#pragma unroll
        for (int a = 0; a < 2; ++a)
#pragma unroll
            for (int b = 0; b < 2; ++b)
#pragma unroll
                for (int m = 0; m < 4; ++m)
#pragma unroll
                    for (int n = 0; n < 2; ++n) acc[a][b][m][n] = (f32x4){0.f, 0.f, 0.f, 0.f};
        cur = nxt; cA = nA; cB = nB; ++ui;
        if constexpr (GATHER) {
#pragma unroll
            for (int h = 0; h < 2; ++h)
#pragma unroll
                for (int i = 0; i < 2; ++i) gC[h][i] = gN[h][i];
        }
        if (wr == 1) PG8_BAR;
    }
    PG8_WAIT_V(0);
    PG8_BAR;
#undef PG8_SA
#undef PG8_SB
#undef PG8_STAGE
#undef PG8_LDA
#undef PG8_LDB
#undef PG8_MMA
#undef PG8_WAIT_V
#undef PG8_WAIT_L
#undef PG8_BAR
#undef PG8_SCHED
}
}

constexpr size_t MiB = 1u << 20;
constexpr size_t WS_CTL = 0, CTL_ZERO_BYTES = 1 * MiB;
constexpr size_t WS_COS = 1 * MiB, WS_SIN = 5 * MiB;
constexpr size_t WS_WAIN = 9 * MiB;
constexpr size_t WS_WAOUT = 21 * MiB;
constexpr size_t WS_WBIN = 25 * MiB;
constexpr size_t WS_WBOUT = 37 * MiB;
constexpr size_t WS_WCIN = 41 * MiB;
constexpr size_t WS_WCOUT = 53 * MiB;
constexpr size_t WS_WPROJ = 59 * MiB;
constexpr size_t WS_WGATE = 61 * MiB;
constexpr size_t WS_WGU = 69 * MiB;
constexpr size_t WS_WDN = 101 * MiB;
constexpr size_t WS_XP = 117 * MiB, WS_XQ = 149 * MiB;
constexpr size_t WS_PB = 181 * MiB;
constexpr size_t WS_ROUTE = 189 * MiB;
constexpr size_t WS_S1 = 192 * MiB;
constexpr size_t WS_R = 224 * MiB;
constexpr size_t WS_END = 512 * MiB;
constexpr size_t R_BG = 0, R_Z = 32 * MiB, R_YC = 64 * MiB;
constexpr size_t R_QP = 0, R_KP = 32 * MiB, R_KT = 64 * MiB, R_VT = 96 * MiB, R_GS = 160 * MiB, R_CR = 224 * MiB;
constexpr size_t R_U = 0, R_CVT = 96 * MiB, R_ST = 192 * MiB;
constexpr size_t R_H = 0, R_YS = 36 * MiB, R_X2 = 108 * MiB, R_EMB = 140 * MiB;
constexpr size_t R_X2Q = 0, R_WGQ = 16 * MiB, R_CS = 17 * MiB, R_XS = 17 * MiB + 65536;
static_assert((size_t)NSLOT * DE * 2 <= 36 * MiB && (size_t)NSLOT * D * 2 <= 72 * MiB, "MoE slot buffers");
constexpr int CW_BAR = 4096;
constexpr int CW_AGG = 65536;
constexpr int CW_RDY = 32768;
constexpr int CW_CNT = 16384;

constexpr int RING_OFF = 0, RING_BYTES = 131072;
constexpr int LDSCTL_OFF = RING_BYTES, MISC_OFF = LDSCTL_OFF + 320, TAB_OFF = LDSCTL_OFF + 512;
constexpr int XPOSE_OFF = LDSCTL_OFF + 1024;
constexpr int LDS_BYTES = 163840;
constexpr int NWAVES = 8;

#define XB_TMO      128
#define XB_XCNT(j)  (256  + 64 * (j))
#define XB_XSUB(j)  (1280 + 64 * (j))
#define XB_XGEN(j)  (2304 + 64 * (j))
#define XB_TOP      3328
#define XB_TOPGEN   3392
#define XCD_BAR_WORDS 3456
#define XB_SPIN_CAP (1u << 22)
DI unsigned xb_ld(unsigned* p)              { return __hip_atomic_load(p, __ATOMIC_RELAXED, __HIP_MEMORY_SCOPE_AGENT); }
DI unsigned xb_add(unsigned* p, unsigned v) { return __hip_atomic_fetch_add(p, v, __ATOMIC_RELAXED, __HIP_MEMORY_SCOPE_AGENT); }
DI unsigned xb_xcc_id() { return (unsigned)__builtin_amdgcn_s_getreg((3 << 11) | 20) & 0xFu; }
#define XB_SPIN(cond, bar) do { unsigned _sp = 0; while (cond) { __builtin_amdgcn_s_sleep(1); \
    if ((++_sp & 255u) == 0u) { if (xb_ld(&(bar)[XB_TMO])) break; if (_sp > XB_SPIN_CAP) { atomicAdd(&(bar)[XB_TMO], 1u); break; } } } } while (0)
struct XcdBarrier { unsigned* bar; unsigned x; volatile LAS unsigned* st; };
DI XcdBarrier xcd_barrier_post(unsigned* bar, volatile LAS unsigned* st, bool t0) {
    XcdBarrier b; b.bar = bar; b.x = xb_xcc_id(); b.st = st;
    if (t0) (void)xb_add(&bar[XB_XCNT(b.x)], 1u);
    return b;
}
DI void xcd_barrier_complete(unsigned* bar, unsigned x, unsigned& nloc, unsigned& nx) {
    const unsigned G = gridDim.x * gridDim.y * gridDim.z;
    unsigned sum, cnt, mine, sp = 0u;
    for (;;) {
        sum = 0u; cnt = 0u; mine = 0u;
#pragma unroll
        for (unsigned j = 0; j < 16; ++j) { const unsigned c = xb_ld(&bar[XB_XCNT(j)]); sum += c; cnt += (c > 0u) ? 1u : 0u; mine = (j == x) ? c : mine; }
        if (sum == G) break;
        __builtin_amdgcn_s_sleep(1);
        if ((++sp & 255u) == 0u) { if (xb_ld(&bar[XB_TMO])) break; if (sp > XB_SPIN_CAP) { atomicAdd(&bar[XB_TMO], 1u); break; } }
    }
    nloc = mine > 0u ? mine : 1u; nx = cnt > 0u ? cnt : 1u;
}
DI void xcd_barrier(const XcdBarrier& b, bool t0) {
    asm volatile("s_waitcnt vmcnt(0)" ::: "memory");
    __syncthreads();
    if (t0) {
        unsigned* bar = b.bar;
        __builtin_amdgcn_s_waitcnt(0);
        unsigned nloc = b.st[0], nx = b.st[1];
        if (nloc == 0u) { xcd_barrier_complete(bar, b.x, nloc, nx); b.st[0] = nloc; b.st[1] = nx; }
        const unsigned old = xb_add(&bar[XB_XSUB(b.x)], 1u);
        asm volatile("buffer_inv sc1" ::: "memory");
        const unsigned gen = old / nloc;
        if (old + 1u == (gen + 1u) * nloc) {
            __builtin_amdgcn_fence(__ATOMIC_RELEASE, "agent");
            asm volatile("s_waitcnt vmcnt(0)" ::: "memory");
            const unsigned og = xb_add(&bar[XB_TOP], 1u);
            const unsigned tg = og / nx;
            if (og + 1u == (tg + 1u) * nx) xb_add(&bar[XB_TOPGEN], 1u);
            else XB_SPIN(xb_ld(&bar[XB_TOPGEN]) == tg, bar);
            xb_add(&bar[XB_XGEN(b.x)], 1u);
            asm volatile("s_waitcnt vmcnt(0)" ::: "memory");
        } else {
            XB_SPIN(xb_ld(&bar[XB_XGEN(b.x)]) == gen, bar);
            asm volatile("s_waitcnt vmcnt(0)" ::: "memory");
        }
    }
    __syncthreads();
}

struct Frame {
    LAS unsigned char* lds;
    unsigned* ctl;
    unsigned char* ws;
    int tid, lane, wave, vcu, G, bx;
};
struct Args { const void* in[23]; float* out; unsigned char* ws; int ph_lo, ph_hi; };
enum { I_X = 0, I_P, I_AWIN, I_ACONV, I_AWOUT, I_BWIN, I_BWOUT, I_CWIN, I_CLNG, I_CLNB, I_CWS, I_CBS, I_CWOUT, I_RW, I_RB, I_MG, I_MU, I_MD, I_LNG, I_LNB, I_PPROJ, I_PGATE, I_PBG };
typedef const __attribute__((address_space(4))) Args CArgs;
DI CArgs* kargs() { unsigned long long p = (unsigned long long)__builtin_amdgcn_kernarg_segment_ptr(); asm volatile("" : "+s"(p)); return (CArgs*)p; }
DI int cur_tid(int wv) { int w = wv; unsigned m = ~0u; asm volatile("" : "+s"(w), "+s"(m)); return w * 64 + (int)__builtin_amdgcn_mbcnt_hi(m, __builtin_amdgcn_mbcnt_lo(m, 0u)); }
DI Frame mkframe(CArgs* ap, int wv) {
    extern __shared__ __attribute__((aligned(16))) unsigned char lds[];
    int tid = cur_tid(wv), bx = blockIdx.x, G = gridDim.x;
    asm volatile("" : "+v"(tid)); asm volatile("" : "+s"(bx)); asm volatile("" : "+s"(G));
    Frame F; F.lds = (LAS unsigned char*)lds; F.tid = tid; F.lane = F.tid & 63; F.wave = __builtin_amdgcn_readfirstlane(F.tid >> 6);
    F.G = G; F.bx = bx; F.vcu = (F.G % 8 == 0) ? (bx % 8) * (F.G / 8) + bx / 8 : bx;
    F.ws = ap->ws; F.ctl = (unsigned*)(ap->ws + WS_CTL); return F;
}

DI void cvt_job(Frame& F, const float* W, int ld, int K, int ncols, bf16_t* WT, int rowbase, int mode, int nmat, size_t sstride, size_t dstride, int& base) {
    LAS unsigned char* scr = F.lds + RING_OFF + F.wave * 16384;
    const int gw = F.vcu * NWAVES + F.wave, NGW = F.G * NWAVES, nblk = ncols / 64, per = (K / 64) * nblk, items = per * nmat, lane = F.lane;
    const int first = (gw + NGW - (base % NGW)) % NGW; base += items;
    for (int it = first; it < items; it += NGW) {
        const int mat = it / per, r = it - mat * per, kb = r / nblk, nb = r - kb * nblk, k0 = 64 * kb, n0 = 64 * nb;
        const float* p = W + (size_t)mat * sstride + (size_t)(k0 + (lane >> 4)) * ld + n0 + 4 * (lane & 15);
        f32x4 v[16];
#pragma unroll
        for (int i = 0; i < 16; ++i) v[i] = __builtin_nontemporal_load((const f32x4*)(p + (size_t)(4 * i) * ld));
#pragma unroll
        for (int i = 0; i < 16; ++i) { u32x2 w; w.x = pk2(v[i][0], v[i][1]); w.y = pk2(v[i][2], v[i][3]); *(LAS u32x2*)(scr + ((lane >> 4) + 4 * i) * 136 + (lane & 15) * 8) = w; }
        LDS_WAIT(); asm volatile("" ::: "memory");
        const int r0 = rowbase + (mode == 0 ? n0 : (n0 >> 7) * 256 + (mode - 1) * 128 + (n0 & 127)), c = lane & 7;
        bf16_t* dst = WT + (size_t)mat * dstride + (size_t)r0 * K + k0 + 8 * c;
#pragma unroll
        for (int j = 0; j < 8; ++j) { const int n = (lane >> 3) + 8 * j; const LAS unsigned short* s = (const LAS unsigned short*)(scr + (8 * c) * 136 + n * 2);
            u32x4 o; o.x = (unsigned)s[0] | ((unsigned)s[68] << 16); o.y = (unsigned)s[2 * 68] | ((unsigned)s[3 * 68] << 16); o.z = (unsigned)s[4 * 68] | ((unsigned)s[5 * 68] << 16); o.w = (unsigned)s[6 * 68] | ((unsigned)s[7 * 68] << 16);
            *(u32x4*)(dst + (size_t)n * K) = o; }
        LDS_WAIT(); asm volatile("" ::: "memory");
    }
}
DI void cvt_flat(Frame& F, const float* src, bf16_t* dst, size_t n) {
    const size_t nth = (size_t)F.G * 512, t0 = (size_t)F.vcu * 512 + F.tid;
    for (size_t i = t0; i < n / 8; i += nth) { const f32x4 a = __builtin_nontemporal_load((const f32x4*)(src + i * 8)), b = __builtin_nontemporal_load((const f32x4*)(src + i * 8 + 4)); *(u32x4*)(dst + i * 8) = pk8(a, b); }
}

DI void p0_prologue(Frame& F, CArgs* ap) {
    unsigned char* ws = F.ws;
    int base = 0;
    { const float* w = (const float*)ap->in[I_AWIN]; bf16_t* d = (bf16_t*)(ws + WS_WAIN);
      cvt_job(F, w, 3072, D, 1024, d, 0, 0, 2, (size_t)D * 3072, (size_t)3072 * D, base);
      cvt_job(F, w + 1024, 3072, D, 1024, d, 1024, 1, 2, (size_t)D * 3072, (size_t)3072 * D, base);
      cvt_job(F, w + 2048, 3072, D, 1024, d, 1024, 2, 2, (size_t)D * 3072, (size_t)3072 * D, base); }
    cvt_job(F, (const float*)ap->in[I_AWOUT], D, D, D, (bf16_t*)(ws + WS_WAOUT), 0, 0, 2, (size_t)D * D, (size_t)D * D, base);
    cvt_job(F, (const float*)ap->in[I_BWIN], 6144, D, 6144, (bf16_t*)(ws + WS_WBIN), 0, 0, 1, 0, 0, base);
    cvt_job(F, (const float*)ap->in[I_BWOUT], D, VD, D, (bf16_t*)(ws + WS_WBOUT), 0, 0, 1, 0, 0, base);
    cvt_job(F, (const float*)ap->in[I_CWIN], 6144, D, 6144, (bf16_t*)(ws + WS_WCIN), 0, 0, 1, 0, 0, base);
    cvt_job(F, (const float*)ap->in[I_CWOUT], D, SH, D, (bf16_t*)(ws + WS_WCOUT), 0, 0, 1, 0, 0, base);
    cvt_job(F, (const float*)ap->in[I_PPROJ], D, PLE, D, (bf16_t*)(ws + WS_WPROJ), 0, 0, DEPTH, (size_t)PLE * D, (size_t)D * PLE, base);
    cvt_job(F, (const float*)ap->in[I_PGATE], D, D, D, (bf16_t*)(ws + WS_WGATE), 0, 0, DEPTH, (size_t)D * D, (size_t)D * D, base);
    cvt_flat(F, (const float*)ap->in[I_X], (bf16_t*)(ws + WS_XP), (size_t)M * D);
    float* COS = (float*)(ws + WS_COS); float* SIN = (float*)(ws + WS_SIN);
    for (int i = F.vcu * 512 + F.tid; i < SEQ * 128; i += F.G * 512) {
        const int pos = i >> 7, j = i & 127;
        const float lin = (float)j * (1.0f / 127.0f);
        const float invf = 1.0f / __builtin_powf(10000.0f, lin);
        const float ang = (float)pos * invf;
        const double x = (double)ang, k = __builtin_rint(x * 0.15915494309189535);
        double r = x - k * 6.283185307179586; double sgn = 1.0;
        if (r > 1.5707963267948966) { r = 3.141592653589793 - r; sgn = -1.0; } else if (r < -1.5707963267948966) { r = -3.141592653589793 - r; sgn = -1.0; }
        const double r2 = r * r;
        const double sv = r * (1.0 + r2 * (-1.0 / 6 + r2 * (1.0 / 120 + r2 * (-1.0 / 5040 + r2 * (1.0 / 362880 + r2 * (-1.0 / 39916800 + r2 * (1.0 / 6227020800.0)))))));
        const double cv = 1.0 + r2 * (-0.5 + r2 * (1.0 / 24 + r2 * (-1.0 / 720 + r2 * (1.0 / 40320 + r2 * (-1.0 / 3628800 + r2 * (1.0 / 479001600 + r2 * (-1.0 / 87178291200.0)))))));
        COS[i] = (float)(sgn * cv); SIN[i] = (float)sv;
    }
}

DI void phase_conv(Frame& F, const bf16_t* BG, const bf16_t* Z, const float* cw, bf16_t* YC) {
    const int sub = F.tid >> 7, cl = F.tid & 127, c0 = cl * 8;
    float w0[8], w1[8], w2[8];
#pragma unroll
    for (int j = 0; j < 8; ++j) { w0[j] = cw[c0 + j]; w1[j] = cw[D + c0 + j]; w2[j] = cw[2 * D + c0 + j]; }
    for (int run = F.vcu * 4 + sub; run < M / 16; run += F.G * 4) {
        const int t0 = run * 16; const bool first = (t0 & (SEQ - 1)) == 0;
        f32x4 za0, za1, zb0, zb1;
        if (first) { za0 = za1 = zb0 = zb1 = (f32x4){0.f, 0.f, 0.f, 0.f}; }
        else { unpk8(*(const u32x4*)(Z + (size_t)(t0 - 2) * D + c0), za0, za1); unpk8(*(const u32x4*)(Z + (size_t)(t0 - 1) * D + c0), zb0, zb1); }
#pragma unroll 4
        for (int t = t0; t < t0 + 16; ++t) {
            f32x4 z0, z1, b0, b1; unpk8(*(const u32x4*)(Z + (size_t)t * D + c0), z0, z1); unpk8(*(const u32x4*)(BG + (size_t)t * D + c0), b0, b1);
            f32x4 y0, y1;
#pragma unroll
            for (int j = 0; j < 4; ++j) { y0[j] = b0[j] * (w0[j] * za0[j] + w1[j] * zb0[j] + w2[j] * z0[j]); y1[j] = b1[j] * (w0[4 + j] * za1[j] + w1[4 + j] * zb1[j] + w2[4 + j] * z1[j]); }
            *(u32x4*)(YC + (size_t)t * D + c0) = pk8(y0, y1);
            za0 = zb0; za1 = zb1; zb0 = z0; zb1 = z1;
        }
    }
}

DI void ln16(float (&v)[16], const float (&g)[16], const float (&b)[16], int lane) {
    float s = 0.f;
#pragma unroll
    for (int j = 0; j < 16; ++j) s += v[j];
    const float mean = wave_sum(s, lane) * (1.0f / D); float q = 0.f;
#pragma unroll
    for (int j = 0; j < 16; ++j) { v[j] -= mean; q += v[j] * v[j]; }
    const float rstd = __builtin_amdgcn_rsqf(wave_sum(q, lane) * (1.0f / D) + LN_EPS);
#pragma unroll
    for (int j = 0; j < 16; ++j) v[j] = v[j] * rstd * g[j] + b[j];
}
DI void load16(const bf16_t* row, int lane, float (&v)[16]) {
    f32x4 a0, a1, b0, b1; unpk8(*(const u32x4*)(row + 8 * lane), a0, a1); unpk8(*(const u32x4*)(row + 512 + 8 * lane), b0, b1);
#pragma unroll
    for (int j = 0; j < 4; ++j) { v[j] = a0[j]; v[4 + j] = a1[j]; v[8 + j] = b0[j]; v[12 + j] = b1[j]; }
}
DI void load16f(const float* p, int lane, float (&v)[16]) {
#pragma unroll
    for (int j = 0; j < 8; ++j) { v[j] = p[8 * lane + j]; v[8 + j] = p[512 + 8 * lane + j]; }
}
DI void store16(bf16_t* row, int lane, const float (&v)[16]) {
    *(u32x4*)(row + 8 * lane) = pk8((f32x4){v[0], v[1], v[2], v[3]}, (f32x4){v[4], v[5], v[6], v[7]});
    *(u32x4*)(row + 512 + 8 * lane) = pk8((f32x4){v[8], v[9], v[10], v[11]}, (f32x4){v[12], v[13], v[14], v[15]});
}

DI void phase_ln1_route(Frame& F, CArgs* ap, int L, const bf16_t* S1, bf16_t* X1, const bool dry, unsigned char* X1Q) {
    unsigned char* ws = F.ws;
    const int gw = F.vcu * NWAVES + F.wave, NGW = F.G * NWAVES;
    const bool inter = (NGW == 2048);
    if (!inter) {
        { int base = 0; const size_t l0 = (size_t)L * NE;
          cvt_job(F, (const float*)ap->in[I_MG] + l0 * D * DE, DE, D, DE, (bf16_t*)(ws + WS_WGU), 0, 1, NE, (size_t)D * DE, (size_t)1024 * D, base);
          cvt_job(F, (const float*)ap->in[I_MU] + l0 * D * DE, DE, D, DE, (bf16_t*)(ws + WS_WGU), 0, 2, NE, (size_t)D * DE, (size_t)1024 * D, base);
          cvt_job(F, (const float*)ap->in[I_MD] + l0 * DE * D, D, DE, D, (bf16_t*)(ws + WS_WDN), 0, 0, NE, (size_t)DE * D, (size_t)D * DE, base); }
        cvt_flat(F, (const float*)ap->in[I_P] + (size_t)L * M * PLE, (bf16_t*)(ws + WS_PB), (size_t)M * PLE);
        __syncthreads();
    }
    LAS float* RW = (LAS float*)(F.lds + RING_OFF);
    LAS unsigned char* scr = F.wave < 7 ? F.lds + RING_OFF + 65536 + F.wave * 8704 : F.lds + XPOSE_OFF;
    const float* rw = (const float*)ap->in[I_RW];
    for (int i = F.tid; i < D * NE; i += 512) RW[(i & 15) * D + (i >> 4)] = rw[i];
    float g[16], b[16]; load16f((const float*)ap->in[I_LNG] + (size_t)(L * 2 + 0) * D, F.lane, g); load16f((const float*)ap->in[I_LNB] + (size_t)(L * 2 + 0) * D, F.lane, b);
    const float* rb = (const float*)ap->in[I_RB];
    const float rbl = rb[((F.lane >> 5) & 1) * 8 + ((F.lane >> 4) & 1) * 4 + ((F.lane >> 3) & 1) * 2 + ((F.lane >> 2) & 1)];
    int* TOK_E = (int*)(ws + WS_ROUTE); int* TOK_POS = TOK_E + 2 * M; float* TOK_W = (float*)(TOK_POS + 2 * M); int* LIST = (int*)(TOK_W + 2 * M);
    unsigned* cnt = F.ctl + CW_CNT + (size_t)L * NE * 64;
    __syncthreads();
    const float* psrc = (const float*)ap->in[I_P] + (size_t)L * M * PLE; bf16_t* pdst = (bf16_t*)(ws + WS_PB);
    const size_t pth = (size_t)F.G * 512, pt0 = (size_t)F.vcu * 512 + F.tid;
    u32x4 nx0 = *(const u32x4*)(S1 + (size_t)gw * D + 8 * F.lane), nx1 = *(const u32x4*)(S1 + (size_t)gw * D + 512 + 8 * F.lane);
    int kk = 0;
    for (int t = gw; t < M; t += NGW, ++kk) {
        const u32x4 c0 = nx0, c1 = nx1;
        { const int tn = t + NGW < M ? t + NGW : t; nx0 = *(const u32x4*)(S1 + (size_t)tn * D + 8 * F.lane); nx1 = *(const u32x4*)(S1 + (size_t)tn * D + 512 + 8 * F.lane); }
        const bool dot = inter && (kk == 0 || kk == 3 || kk == 6), dop = inter && (kk == 1 || kk == 2 || kk == 4 || kk == 5);
        f32x4 tv[16]; bf16_t* tdst = nullptr; int tK = 0; f32x4 pa = {0.f, 0.f, 0.f, 0.f}, pb = pa; size_t pi = 0; f32x4 tsmp = pa; int tkb = 0, tcs = 0;
        if (dot) {
            const int job = kk / 3, lane = F.lane; const size_t l0 = (size_t)L * NE;
            const float* W = (const float*)ap->in[job == 0 ? I_MG : job == 1 ? I_MU : I_MD] + l0 * D * DE;
            const int ld = job == 2 ? D : DE, K = job == 2 ? DE : D, nblk = job == 2 ? 16 : 8, mode = job == 2 ? 0 : job + 1;
            const int mat = gw >> 7, r = gw & 127, kb = r / nblk, nb = r - kb * nblk, k0 = 64 * kb, n0 = 64 * nb;
            const float* p = W + (size_t)mat * ((size_t)D * DE) + (size_t)(k0 + (lane >> 4)) * ld + n0 + 4 * (lane & 15);
#pragma unroll
            for (int i = 0; i < 16; ++i) tv[i] = __builtin_nontemporal_load((const f32x4*)(p + (size_t)(4 * i) * ld));
            { tsmp = *(const f32x4*)(W + (size_t)mat * ((size_t)D * DE) + (size_t)(lane >> 4) * ld + n0 + 4 * (lane & 15)); tkb = kb; tcs = mat * 1024 + (mode == 0 ? n0 : (n0 >> 7) * 256 + (mode - 1) * 128 + (n0 & 127)); }
            const int r0 = mode == 0 ? n0 : (n0 >> 7) * 256 + (mode - 1) * 128 + (n0 & 127);
            tdst = (bf16_t*)(ws + (job == 2 ? WS_WDN : WS_WGU)) + (size_t)mat * (job == 2 ? (size_t)D * DE : (size_t)1024 * D) + (size_t)r0 * K + k0 + 8 * (lane & 7); tK = K;
            tdst = (bf16_t*)(ws + (job == 2 ? WS_WDN : WS_WGU) + (size_t)mat * (1024 * K) + (size_t)r0 * K + k0 + 8 * (lane & 7));
        } else {
#pragma unroll
            for (int i = 0; i < 16; ++i) tv[i] = (f32x4){0.f, 0.f, 0.f, 0.f};
        }
        if (dop) { pi = pt0 + (size_t)(kk - 1 - (kk > 3 ? 1 : 0)) * pth; pa = __builtin_nontemporal_load((const f32x4*)(psrc + pi * 8)); pb = __builtin_nontemporal_load((const f32x4*)(psrc + pi * 8 + 4)); }
        asm volatile("" ::: "memory");
        float v[16]; { f32x4 a0, a1, b0, b1; unpk8(c0, a0, a1); unpk8(c1, b0, b1);
#pragma unroll
            for (int j = 0; j < 4; ++j) { v[j] = a0[j]; v[4 + j] = a1[j]; v[8 + j] = b0[j]; v[12 + j] = b1[j]; } }
        ln16(v, g, b, F.lane);
        if (!dry) store16(X1 + (size_t)t * D, F.lane, v);
        float xsinv = 0.f;
        if (inter) {
            float am = 0.f;
#pragma unroll
            for (int j = 0; j < 16; ++j) am = __builtin_fmaxf(am, __builtin_fabsf(v[j]));
            am = wave_max_pos(am);
            const int e = am > 0.f ? __builtin_amdgcn_frexp_expf(am) : 0; const float qs = __builtin_amdgcn_ldexpf(1.0f, 7 - e); xsinv = __builtin_amdgcn_ldexpf(1.0f, e - 7);
            u32x2 q0, q1; q0.x = pk4_fp8(v[0] * qs, v[1] * qs, v[2] * qs, v[3] * qs); q0.y = pk4_fp8(v[4] * qs, v[5] * qs, v[6] * qs, v[7] * qs);
            q1.x = pk4_fp8(v[8] * qs, v[9] * qs, v[10] * qs, v[11] * qs); q1.y = pk4_fp8(v[12] * qs, v[13] * qs, v[14] * qs, v[15] * qs);
            if (!dry) { *(u32x2*)(X1Q + (size_t)t * D + 8 * F.lane) = q0; *(u32x2*)(X1Q + (size_t)t * D + 512 + 8 * F.lane) = q1; }
        }
        float sc[16]; int re1 = 0, re2 = 0; float w1 = 0.f, w2 = 0.f;
#pragma unroll
        for (int e = 0; e < NE; ++e) {
            const LAS float* r = RW + e * D;
            const f32x4 r0 = *(const LAS f32x4*)(r + 8 * F.lane), r1 = *(const LAS f32x4*)(r + 8 * F.lane + 4), r2 = *(const LAS f32x4*)(r + 512 + 8 * F.lane), r3 = *(const LAS f32x4*)(r + 512 + 8 * F.lane + 4);
            float p = 0.f;
#pragma unroll
            for (int j = 0; j < 4; ++j) p += v[j] * r0[j] + v[4 + j] * r1[j] + v[8 + j] * r2[j] + v[12 + j] * r3[j];
            sc[e] = p;
            if ((e & 3) == 3) asm volatile("" ::: "memory");
        }
        { const int ln = F.lane;
#pragma unroll
          for (int j = 0; j < 8; ++j) { const float keep = (ln & 32) ? sc[8 + j] : sc[j], give = (ln & 32) ? sc[j] : sc[8 + j]; sc[j] = keep + shx(give, 32, ln); }
#pragma unroll
          for (int j = 0; j < 4; ++j) { const float keep = (ln & 16) ? sc[4 + j] : sc[j], give = (ln & 16) ? sc[j] : sc[4 + j]; sc[j] = keep + shx(give, 16, ln); }
#pragma unroll
          for (int j = 0; j < 2; ++j) { const float keep = (ln & 8) ? sc[2 + j] : sc[j], give = (ln & 8) ? sc[j] : sc[2 + j]; sc[j] = keep + shx(give, 8, ln); }
          { const float keep = (ln & 4) ? sc[1] : sc[0], give = (ln & 4) ? sc[0] : sc[1]; sc[0] = keep + shx(give, 4, ln); }
          DPP_ADD(sc[0], 0xB1, 0xf); DPP_ADD(sc[0], 0x4E, 0xf);
          const float mine = __builtin_amdgcn_rcpf(1.0f + __builtin_amdgcn_exp2f(sc[0] * -1.4426950408889634f));
          const int grp = ln >> 4, mem = (ln >> 2) & 3;
          const float selv = mine + rbl;
          const float v1 = shx(selv, 4, ln), v2 = shx(selv, 8, ln), v3 = shx(selv, 12, ln);
          const float pa = fmaxf(selv, v1), pb = fminf(selv, v1), pc = fmaxf(v2, v3), pd = fminf(v2, v3);
          const float gs = fmaxf(pa, pc) + fmaxf(fminf(pa, pc), fmaxf(pb, pd));
          const float g1 = shx(gs, 16, ln), g2 = shx(gs, 32, ln), g3 = shx(gs, 48, ln);
          const bool inbest = ((gs > g1) || (gs == g1 && grp < (grp ^ 1))) && ((gs > g2) || (gs == g2 && grp < (grp ^ 2))) && ((gs > g3) || (gs == g3 && grp < (grp ^ 3)));
          const int rank = (((v1 > selv) || (v1 == selv && (mem ^ 1) < mem)) ? 1 : 0) + (((v2 > selv) || (v2 == selv && (mem ^ 2) < mem)) ? 1 : 0) + (((v3 > selv) || (v3 == selv && (mem ^ 3) < mem)) ? 1 : 0);
          const unsigned long long mk1 = __builtin_amdgcn_ballot_w64(inbest && rank == 0), mk2 = __builtin_amdgcn_ballot_w64(inbest && rank == 1);
          const int l1 = __builtin_ctzll(mk1 | (1ull << 63)), l2 = __builtin_ctzll(mk2 | (1ull << 63));
          re1 = ((l1 >> 5) & 1) * 8 + ((l1 >> 4) & 1) * 4 + ((l1 >> 3) & 1) * 2 + ((l1 >> 2) & 1); re2 = ((l2 >> 5) & 1) * 8 + ((l2 >> 4) & 1) * 4 + ((l2 >> 3) & 1) * 2 + ((l2 >> 2) & 1);
          w1 = __builtin_bit_cast(float, __builtin_amdgcn_readlane(__builtin_bit_cast(int, mine), l1)); w2 = __builtin_bit_cast(float, __builtin_amdgcn_readlane(__builtin_bit_cast(int, mine), l2));
        }
        const float inv = 1.0f / (w1 + w2);
        if (F.lane == 0 && !dry) {
            const int e1 = re1, e2 = re2;
            const int p1 = (int)xb_add(cnt + e1 * 64, 1u), p2 = (int)xb_add(cnt + e2 * 64, 1u);
            LIST[(size_t)e1 * M + p1] = t; LIST[(size_t)e2 * M + p2] = t;
            if (inter) { float* SL = (float*)(LIST + 16 * M); SL[(size_t)e1 * M + p1] = xsinv; SL[(size_t)e2 * M + p2] = xsinv; }
            TOK_E[2 * t] = e1; TOK_E[2 * t + 1] = e2; TOK_POS[2 * t] = p1; TOK_POS[2 * t + 1] = p2; TOK_W[2 * t] = w1 * inv; TOK_W[2 * t + 1] = w2 * inv;
        }
        if (dot) {
            const int lane = F.lane, c = lane & 7;
#pragma unroll
            for (int i = 0; i < 16; ++i) { u32x2 w; w.x = pk2(tv[i][0], tv[i][1]); w.y = pk2(tv[i][2], tv[i][3]); *(LAS u32x2*)(scr + ((lane >> 4) + 4 * i) * 136 + (lane & 15) * 8) = w; }
            LDS_WAIT(); asm volatile("" ::: "memory");
            if (true) {
                float am = __builtin_fmaxf(__builtin_fmaxf(__builtin_fabsf(tsmp[0]), __builtin_fabsf(tsmp[1])), __builtin_fmaxf(__builtin_fabsf(tsmp[2]), __builtin_fabsf(tsmp[3])));
                am = wave_max_pos(am);
                const int e = am > 0.f ? __builtin_amdgcn_frexp_expf(am) : 0; const float qs = __builtin_amdgcn_ldexpf(1.0f, 6 - e);
                if (tkb == 0) ((float*)(kk < 6 ? ws + WS_WGU + 16 * MiB : ws + WS_WDN + 8 * MiB))[tcs + lane] = __builtin_amdgcn_ldexpf(1.0f, e - 6);
#pragma unroll
                for (int j = 0; j < 8; ++j) { const int n = (lane >> 3) + 8 * j; const LAS unsigned short* s = (const LAS unsigned short*)(scr + (8 * c) * 136 + n * 2);
                    float f[8];
#pragma unroll
                    for (int q = 0; q < 8; ++q) f[q] = __builtin_bit_cast(float, (unsigned)s[q * 68] << 16) * qs;
                    u32x2 o; o.x = pk4_fp8(f[0], f[1], f[2], f[3]); o.y = pk4_fp8(f[4], f[5], f[6], f[7]);
                    *(u32x2*)((unsigned char*)tdst + (size_t)n * tK) = o; }
            } else {
#pragma unroll
            for (int j = 0; j < 8; ++j) { const int n = (lane >> 3) + 8 * j; const LAS unsigned short* s = (const LAS unsigned short*)(scr + (8 * c) * 136 + n * 2);
                u32x4 o; o.x = (unsigned)s[0] | ((unsigned)s[68] << 16); o.y = (unsigned)s[2 * 68] | ((unsigned)s[3 * 68] << 16); o.z = (unsigned)s[4 * 68] | ((unsigned)s[5 * 68] << 16); o.w = (unsigned)s[6 * 68] | ((unsigned)s[7 * 68] << 16);
                *(u32x4*)(tdst + (size_t)n * tK) = o; }
            }
            LDS_WAIT(); asm volatile("" ::: "memory");
        }
        if (dop) *(u32x4*)(pdst + pi * 8) = pk8(pa, pb);
    }
    __syncthreads();
}
DI int moe_c2(const Frame& F, int n1) {
    if (F.G % 8 != 0 || n1 <= 0 || n1 >= F.G) return F.vcu;
    if (F.bx < n1) return F.bx;
    const int per = F.G / 8, x = F.vcu / per, i = F.vcu % per;
    int before = 0;
#pragma unroll
    for (int xx = 0; xx < 8; ++xx) { const int cnt = n1 > xx ? (n1 - xx + 7) / 8 : 0; before += xx < x ? cnt : (xx == x ? (i < cnt ? i : cnt) : 0); }
    return n1 + (F.vcu - before);
}
DI void moe_table(Frame& F, int L) {
    LAS int* tab = (LAS int*)(F.lds + TAB_OFF);
    if (F.tid < 64) {
        unsigned* cnt = F.ctl + CW_CNT + (size_t)L * NE * 64; const int ln = F.lane;
        const int c = ln < NE ? (int)xb_ld(cnt + ln * 64) : 0; int t = (c + 255) >> 8;
#pragma unroll
        for (int o = 1; o < 16; o <<= 1) { const int up = __builtin_amdgcn_ds_bpermute(((ln - o) & 63) << 2, t); if ((ln & 15) >= o) t += up; }
        if (ln < NE) { tab[ln + 1] = t; tab[32 + ln] = c; }
        if (ln == 0) tab[0] = 0;
    }
    __syncthreads();
}
DI void phase_ln2(Frame& F, CArgs* ap, int L, const bf16_t* X1, const bf16_t* YS, bf16_t* X2, unsigned char* X2Q, float* XS, unsigned char* WGQ, float* CS) {
    LAS int* tab = (LAS int*)(F.lds + TAB_OFF);
    { const int n = F.vcu * NWAVES + F.wave;
      if (n < D) { const bf16_t* wr = (const bf16_t*)(F.ws + WS_WGATE) + (size_t)L * D * D + (size_t)n * D + 16 * F.lane;
          f32x4 a0, a1, b0, b1; unpk8(*(const u32x4*)wr, a0, a1); unpk8(*(const u32x4*)(wr + 8), b0, b1);
          float am = 0.f;
#pragma unroll
          for (int j = 0; j < 4; ++j) am = __builtin_fmaxf(am, __builtin_fmaxf(__builtin_fmaxf(__builtin_fabsf(a0[j]), __builtin_fabsf(a1[j])), __builtin_fmaxf(__builtin_fabsf(b0[j]), __builtin_fabsf(b1[j]))));
          am = wave_max_pos(am);
          const int e = am > 0.f ? __builtin_amdgcn_frexp_expf(am) : 0; const float sc = __builtin_amdgcn_ldexpf(1.0f, 7 - e);
          u32x4 o; o.x = pk4_fp8(a0[0] * sc, a0[1] * sc, a0[2] * sc, a0[3] * sc); o.y = pk4_fp8(a1[0] * sc, a1[1] * sc, a1[2] * sc, a1[3] * sc);
          o.z = pk4_fp8(b0[0] * sc, b0[1] * sc, b0[2] * sc, b0[3] * sc); o.w = pk4_fp8(b1[0] * sc, b1[1] * sc, b1[2] * sc, b1[3] * sc);
          *(u32x4*)(WGQ + (size_t)n * D + 16 * F.lane) = o;
          if (F.lane == 0) CS[n] = __builtin_amdgcn_ldexpf(1.0f, e - 7); } }
    float g[16], b[16]; load16f((const float*)ap->in[I_LNG] + (size_t)(L * 2 + 1) * D, F.lane, g); load16f((const float*)ap->in[I_LNB] + (size_t)(L * 2 + 1) * D, F.lane, b);
    const int* TOK_E = (const int*)(F.ws + WS_ROUTE); const int* TOK_POS = TOK_E + 2 * M; const float* TOK_W = (const float*)(TOK_POS + 2 * M);
    const int gw = F.vcu * NWAVES + F.wave, NGW = F.G * NWAVES;
    struct Rec { int e1, e2, p1, p2; float w1, w2; };
    struct Rows { u32x4 x[2], a[2], b[2]; };
    auto ld_rec = [&](int t) { Rec r; r.e1 = TOK_E[2 * t]; r.e2 = TOK_E[2 * t + 1]; r.p1 = TOK_POS[2 * t]; r.p2 = TOK_POS[2 * t + 1]; r.w1 = TOK_W[2 * t]; r.w2 = TOK_W[2 * t + 1]; return r; };
    auto ld_rows = [&](int t, const Rec& r) { Rows o; const size_t s1 = (size_t)tab[r.e1] * 256 + r.p1, s2 = (size_t)tab[r.e2] * 256 + r.p2;
        const bf16_t* px = X1 + (size_t)t * D + 8 * F.lane; const bf16_t* pa = YS + s1 * D + 8 * F.lane; const bf16_t* pb = YS + s2 * D + 8 * F.lane;
        o.x[0] = *(const u32x4*)px; o.x[1] = *(const u32x4*)(px + 512); o.a[0] = *(const u32x4*)pa; o.a[1] = *(const u32x4*)(pa + 512); o.b[0] = *(const u32x4*)pb; o.b[1] = *(const u32x4*)(pb + 512); return o; };
    if (gw < M) {
        Rec rc = ld_rec(gw); Rec rn = ld_rec(gw + NGW < M ? gw + NGW : gw);
        Rows cur = ld_rows(gw, rc);
        for (int t = gw; t < M; t += NGW) {
            const int t1 = t + NGW < M ? t + NGW : t, t2 = t + 2 * NGW < M ? t + 2 * NGW : t1;
            const Rows nxt = ld_rows(t1, rn); const Rec rnn = ld_rec(t2);
            float v[16];
#pragma unroll
            for (int hh = 0; hh < 2; ++hh) { f32x4 x0, x1, a0, a1, b0, b1; unpk8(cur.x[hh], x0, x1); unpk8(cur.a[hh], a0, a1); unpk8(cur.b[hh], b0, b1);
#pragma unroll
                for (int j = 0; j < 4; ++j) { v[8 * hh + j] = ALPHA * x0[j] + rc.w1 * a0[j] + rc.w2 * b0[j]; v[8 * hh + 4 + j] = ALPHA * x1[j] + rc.w1 * a1[j] + rc.w2 * b1[j]; } }
            ln16(v, g, b, F.lane);
            store16(X2 + (size_t)t * D, F.lane, v);
            { float am = 0.f;
#pragma unroll
              for (int j = 0; j < 16; ++j) am = __builtin_fmaxf(am, __builtin_fabsf(v[j]));
              am = wave_max_pos(am);
              const int e = am > 0.f ? __builtin_amdgcn_frexp_expf(am) : 0; const float sc = __builtin_amdgcn_ldexpf(1.0f, 7 - e);
              u32x2 q0, q1; q0.x = pk4_fp8(v[0] * sc, v[1] * sc, v[2] * sc, v[3] * sc); q0.y = pk4_fp8(v[4] * sc, v[5] * sc, v[6] * sc, v[7] * sc);
              q1.x = pk4_fp8(v[8] * sc, v[9] * sc, v[10] * sc, v[11] * sc); q1.y = pk4_fp8(v[12] * sc, v[13] * sc, v[14] * sc, v[15] * sc);
              *(u32x2*)(X2Q + (size_t)t * D + 8 * F.lane) = q0; *(u32x2*)(X2Q + (size_t)t * D + 512 + 8 * F.lane) = q1;
              if (F.lane == 0) XS[t] = __builtin_amdgcn_ldexpf(1.0f, e - 7); }
            cur = nxt; rc = rn; rn = rnn;
        }
    }
}

typedef __amdgpu_buffer_rsrc_t rsrc_t;
DI rsrc_t mk_rsrc(const void* p, unsigned nbytes) { return __builtin_amdgcn_make_buffer_rsrc((void*)p, (short)0, (int)nbytes, 0x00020000); }
DI bf16x8 bload(rsrc_t r, unsigned voff, unsigned soff) { return __builtin_bit_cast(bf16x8, __builtin_amdgcn_raw_buffer_load_b128(r, (int)voff, (int)soff, 0)); }
DI bf16x8 mk_frag(f32x4 a, f32x4 b) { return __builtin_bit_cast(bf16x8, pk8(a, b)); }
#define MFMA16(a, b, c) __builtin_amdgcn_mfma_f32_16x16x32_bf16((a), (b), (c), 0, 0, 0)

struct ScanK { bf16x8 ka0[4], ka1[4]; };
DI void scan_load_k(ScanK& o, rsrc_t rk, int chunk, int h, int w, unsigned vl) {
    const unsigned ok = ((unsigned)chunk * D + (unsigned)(h * DK + 32 * w)) * (CH * 2);
#pragma unroll
    for (int kk = 0; kk < 4; ++kk) { o.ka0[kk] = bload(rk, vl, ok + kk * 1024); o.ka1[kk] = bload(rk, vl, ok + 4096 + kk * 1024); }
}
DI void scan_load_q(bf16x8 (&qf)[8], rsrc_t rq, int chunk, int h, int w, unsigned vl) {
    const unsigned oq = (((unsigned)chunk * 8u + (unsigned)w) * 128u + 4u * (unsigned)(h * 8)) * 256u;
#pragma unroll
    for (int kb = 0; kb < 8; ++kb) qf[kb] = bload(rq, vl, oq + kb * 1024);
}
DI void phase_ret_scan(Frame& F, const bf16_t* QP, const bf16_t* KT, const bf16_t* VT, bf16_t* CR, bf16_t* S32) {
    const int lane = F.lane, w = F.wave;
    LAS unsigned char* SB = F.lds + RING_OFF;
    LAS unsigned char* VS = F.lds + RING_OFF + 32768;
    constexpr int NC = SEQ / CH / 2;
    for (int item = F.vcu; item < NB * RH * 2 * 16; item += F.G) {
        const int es = item & 15, seg = (item >> 4) & 1, bh = item >> 5, bb = bh >> 2, h = bh & 3;
        const float gam = 1.0f - __builtin_amdgcn_exp2f(-5.0f - (float)h), lg2 = __log2f(gam);
        const float cd = __builtin_amdgcn_exp2f(128.0f * lg2), kd = __builtin_amdgcn_exp2f(127.0f * lg2);
        f32x4 R0[2] = {{0.f, 0.f, 0.f, 0.f}, {0.f, 0.f, 0.f, 0.f}}, R1[2] = {{0.f, 0.f, 0.f, 0.f}, {0.f, 0.f, 0.f, 0.f}};
        const int e0 = h * DV + es * 32, c0 = bb * (SEQ / CH) + seg * NC;
        const unsigned vl = (unsigned)lane * 16u;
        const rsrc_t rq = mk_rsrc(QP, (unsigned)M * D * 2u), rk = mk_rsrc(KT, (unsigned)M * D * 2u), rv = mk_rsrc(VT, (unsigned)M * VD * 2u);
        const unsigned vfo = (unsigned)(e0 + (w >> 2) * 16) * (CH * 2) + (unsigned)(w & 3) * 1024u;
        ScanK A, B; bf16x8 qf[8];
        scan_load_k(A, rk, c0, h, w, vl);
        bf16x8 vpre = bload(rv, vl, (unsigned)c0 * VD * (CH * 2) + vfo);
        scan_load_q(qf, rq, c0, h, w, vl);
        *(LAS bf16x8*)(VS + w * 1024 + vl) = vpre; vpre = bload(rv, vl, (unsigned)(c0 + 1) * VD * (CH * 2) + vfo);
        scan_load_k(B, rk, c0 + 1, h, w, vl);
        LDS_WAIT(); __builtin_amdgcn_s_barrier(); asm volatile("" ::: "memory");
#define SCAN_STEP(O, ci) do { \
            const int chunk = c0 + (ci); LAS unsigned char* sb = SB + ((ci) & 1) * 16384; const LAS unsigned char* vs = VS + ((ci) & 1) * 8192; \
            _Pragma("unroll") for (int eb = 0; eb < 2; ++eb) *(LAS bf16x8*)(sb + (eb * 8 + w) * 1024 + vl) = mk_frag(R0[eb] * gam, R1[eb] * gam); \
            f32x4 U0[2] = {{0.f, 0.f, 0.f, 0.f}, {0.f, 0.f, 0.f, 0.f}}, U1[2] = {{0.f, 0.f, 0.f, 0.f}, {0.f, 0.f, 0.f, 0.f}}; \
            _Pragma("unroll") for (int eb = 0; eb < 2; ++eb) _Pragma("unroll") for (int kk = 0; kk < 4; ++kk) { const bf16x8 vb = *(const LAS bf16x8*)(vs + (eb * 4 + kk) * 1024 + vl); \
                U0[eb] = MFMA16(O.ka0[kk], vb, U0[eb]); U1[eb] = MFMA16(O.ka1[kk], vb, U1[eb]); } \
            scan_load_k(O, rk, c0 + ((ci) + 2 < NC ? (ci) + 2 : NC - 1), h, w, vl); \
            *(LAS bf16x8*)(VS + (((ci) + 1) & 1) * 8192 + w * 1024 + vl) = vpre;          \
            vpre = bload(rv, vl, (unsigned)(c0 + ((ci) + 2 < NC ? (ci) + 2 : NC - 1)) * VD * (CH * 2) + vfo); \
            _Pragma("unroll") for (int eb = 0; eb < 2; ++eb) { R0[eb] = R0[eb] * cd + U0[eb] * kd; R1[eb] = R1[eb] * cd + U1[eb] * kd; } \
            LDS_WAIT(); __builtin_amdgcn_s_barrier(); asm volatile("" ::: "memory"); \
            _Pragma("unroll") for (int eb = 0; eb < 2; ++eb) { f32x4 t = {0.f, 0.f, 0.f, 0.f}; \
                _Pragma("unroll") for (int kb = 0; kb < 8; ++kb) t = MFMA16(*(const LAS bf16x8*)(sb + (eb * 8 + kb) * 1024 + vl), qf[kb], t); \
                u32x2 o; o.x = pk2(t[0], t[1]); o.y = pk2(t[2], t[3]); *(u32x2*)(CR + ((((size_t)chunk * 4 + h) * 8 + w) * 32 + (es * 2 + eb)) * 256 + lane * 4) = o; } \
            scan_load_q(qf, rq, c0 + ((ci) + 1 < NC ? (ci) + 1 : NC - 1), h, w, vl); } while (0)
        for (int ci = 0; ci < NC; ci += 2) { SCAN_STEP(A, ci); SCAN_STEP(B, ci + 1); }
#undef SCAN_STEP
        if (seg == 0) {
#pragma unroll
            for (int eb = 0; eb < 2; ++eb) *(bf16x8*)((char*)S32 + (((size_t)(bh * 32 + es * 2 + eb)) * 8 + w) * 1024 + vl) = mk_frag(R0[eb], R1[eb]);
        }
        LDS_WAIT(); __builtin_amdgcn_s_barrier(); asm volatile("" ::: "memory");
    }
}

DI void intra_dma8(LAS unsigned char* dst, const char* src, size_t blk_stride, int w, unsigned vl) {
#pragma unroll
    for (int i = 0; i < 8; ++i) __builtin_amdgcn_global_load_lds((const unsigned*)(src + (size_t)i * blk_stride + w * 1024 + vl), (LAS unsigned*)(dst + i * 8192 + w * 1024), 16, 0, 0);
}
DI void phase_ret_intra(Frame& F, const bf16_t* QP, const bf16_t* KP, const bf16_t* VT, const bf16_t* CR, const bf16_t* S32, bf16_t* GS, const bool dry) {
    const int lane = F.lane, w = F.wave, l15 = lane & 15, q = lane >> 4;
    const unsigned vl = (unsigned)lane * 16u;
    LAS unsigned char* QB = F.lds + RING_OFF; LAS unsigned char* KB = F.lds + RING_OFF + 65536;
    for (int unit = F.vcu; unit < NB * RH * (SEQ / CH); unit += F.G) {
        const int h = (unit >> 6) & 3, bb = unit >> 8, ci = (unit & 63) ^ (bb << 5);
        const int chunk = bb * (SEQ / CH) + ci; const size_t tok0 = (size_t)chunk * CH; const size_t row = tok0 + 16 * w + l15;
        intra_dma8(QB, (const char*)QP + ((size_t)chunk * 8 * 128 + 32 * h) * 256, 128 * 256, w, vl);
        intra_dma8(KB, (const char*)KP + ((size_t)chunk * 8 * 128 + 32 * h) * 256, 128 * 256, w, vl);
        asm volatile("s_waitcnt vmcnt(0)" ::: "memory"); __builtin_amdgcn_s_barrier(); asm volatile("" ::: "memory");
        bf16x8 qb[8];
#pragma unroll
        for (int ks = 0; ks < 8; ++ks) qb[ks] = *(const LAS bf16x8*)(QB + w * 8192 + ks * 1024 + vl);
        const int nkp = (w >> 1) + 1, cl = 16 * w + l15;
        bf16x8 sfrag[4];
#pragma unroll
        for (int kp = 0; kp < 4; ++kp) {
            f32x4 st[2] = {{0.f, 0.f, 0.f, 0.f}, {0.f, 0.f, 0.f, 0.f}};
            if (kp < nkp) {
#pragma unroll
                for (int u2 = 0; u2 < 2; ++u2) {
                    f32x4 acc = {0.f, 0.f, 0.f, 0.f};
#pragma unroll
                    for (int ks = 0; ks < 8; ++ks) acc = MFMA16(*(const LAS bf16x8*)(KB + (2 * kp + u2) * 8192 + ks * 1024 + vl), qb[ks], acc);
#pragma unroll
                    for (int r = 0; r < 4; ++r) if (32 * kp + 8 * q + 4 * u2 + r > cl) acc[r] = 0.f;
                    st[u2] = acc;
                }
            }
            sfrag[kp] = mk_frag(st[0], st[1]);
        }
        asm volatile("s_waitcnt lgkmcnt(0)" ::: "memory"); __builtin_amdgcn_s_barrier(); asm volatile("" ::: "memory");
        { const char* vsrc = (const char*)VT + ((size_t)chunk * VD + h * DV) * (CH * 2);
          intra_dma8(QB, vsrc, 8192, w, vl); intra_dma8(KB, vsrc + 65536, 8192, w, vl); }
        u32x2 cpre[32];
#pragma unroll
        for (int eb = 0; eb < 32; ++eb) cpre[eb] = *(const u32x2*)(CR + ((((size_t)chunk * 4 + h) * 8 + w) * 32 + eb) * 256 + lane * 4);
        asm volatile("s_waitcnt vmcnt(0)" ::: "memory"); __builtin_amdgcn_s_barrier(); asm volatile("" ::: "memory");
        f32x4 acc[32];
#pragma unroll
        for (int eb = 0; eb < 32; ++eb) {
            f32x4 a4 = {0.f, 0.f, 0.f, 0.f};
            const LAS unsigned char* vb = (eb < 16 ? QB : KB) + (eb & 15) * 4096 + vl;
#pragma unroll
            for (int kp = 0; kp < 4; ++kp) if (kp < nkp) a4 = MFMA16(*(const LAS bf16x8*)(vb + kp * 1024), sfrag[kp], a4);
            acc[eb] = a4;
        }
#pragma unroll
        for (int eb = 0; eb < 32; ++eb) { const u32x2 cw = cpre[eb]; acc[eb] += (f32x4){bf_lo(cw.x), bf_hi(cw.x), bf_lo(cw.y), bf_hi(cw.y)}; }
        if (ci >= SEQ / CH / 2) {
            const float gam = 1.0f - __builtin_amdgcn_exp2f(-5.0f - (float)h), fc = gam * __builtin_amdgcn_exp2f((float)(128 * (ci - SEQ / CH / 2)) * __log2f(gam));
            bf16x8 qb2[8];
#pragma unroll
            for (int ks = 0; ks < 8; ++ks) qb2[ks] = *(const bf16x8*)((const char*)QP + (((size_t)chunk * 8 + w) * 128 + 4 * (h * 8 + ks)) * 256 + vl);
#pragma unroll
            for (int p = 0; p < 2; ++p) {
                asm volatile("s_waitcnt lgkmcnt(0)" ::: "memory"); __builtin_amdgcn_s_barrier(); asm volatile("" ::: "memory");
                { const char* ssrc = (const char*)S32 + ((size_t)((bb * RH + h) * 32 + 16 * p) * 8) * 1024; intra_dma8(QB, ssrc, 8192, w, vl); intra_dma8(KB, ssrc + 65536, 8192, w, vl); }
                asm volatile("s_waitcnt vmcnt(0)" ::: "memory"); __builtin_amdgcn_s_barrier(); asm volatile("" ::: "memory");
#pragma unroll
                for (int ebl = 0; ebl < 16; ++ebl) {
                    f32x4 t = {0.f, 0.f, 0.f, 0.f};
                    const LAS unsigned char* sbp = (ebl < 8 ? QB : KB) + (ebl & 7) * 8192 + vl;
#pragma unroll
                    for (int ks = 0; ks < 8; ++ks) t = MFMA16(*(const LAS bf16x8*)(sbp + ks * 1024), qb2[ks], t);
                    acc[16 * p + ebl] += t * fc;
                }
            }
        }
        u32x2 gpre[32];
#pragma unroll
        for (int eb = 0; eb < 32; ++eb) gpre[eb] = *(const u32x2*)(GS + row * VD + h * DV + eb * 16 + 4 * q);
        float s = 0.f;
#pragma unroll
        for (int eb = 0; eb < 32; ++eb) s += (acc[eb][0] + acc[eb][1]) + (acc[eb][2] + acc[eb][3]);
        s += shx(s, 16, lane); s += shx(s, 32, lane);
        const float mean = s * (1.0f / DV); float qq = 0.f;
#pragma unroll
        for (int eb = 0; eb < 32; ++eb) { acc[eb] -= mean; qq += (acc[eb][0] * acc[eb][0] + acc[eb][1] * acc[eb][1]) + (acc[eb][2] * acc[eb][2] + acc[eb][3] * acc[eb][3]); }
        qq += shx(qq, 16, lane); qq += shx(qq, 32, lane);
        const float rstd = __builtin_amdgcn_rsqf(qq * (1.0f / DV) + LN_EPS);
#pragma unroll
        for (int eb = 0; eb < 32; ++eb) { bf16_t* gp = GS + row * VD + h * DV + eb * 16 + 4 * q; const u32x2 gw = gpre[eb];
            const f32x4 o = acc[eb] * rstd; u32x2 ov; ov.x = pk2(bf_lo(gw.x) * o[0], bf_hi(gw.x) * o[1]); ov.y = pk2(bf_lo(gw.y) * o[2], bf_hi(gw.y) * o[3]); if (!dry) *(u32x2*)gp = ov; }
        asm volatile("s_waitcnt lgkmcnt(0)" ::: "memory"); __builtin_amdgcn_s_barrier(); asm volatile("" ::: "memory");
    }
}

DI void sgu_dma(LAS unsigned char* dst, const char* src, int w, unsigned vl) {
#pragma unroll
    for (int i = 0; i < 8; ++i) __builtin_amdgcn_global_load_lds((const unsigned*)(src + i * 8192 + w * 1024 + vl), (LAS unsigned*)(dst + i * 8192 + w * 1024), 16, 0, 0);
}
DI void phase_sgu(Frame& F, CArgs* ap, bf16_t* U, const bf16_t* VT, const f32x2* ST, const bool dry) {
    const int lane = F.lane, w = F.wave, l15 = lane & 15, q = lane >> 4;
    LAS float* MU = (LAS float*)(F.lds + LDSCTL_OFF + 2048); LAS float* RS = MU + CH;
    LAS float* LGs = (LAS float*)(F.lds + LDSCTL_OFF + 4096); LAS float* LBs = LGs + SH;
    LAS unsigned char* VB = F.lds + RING_OFF;
    const unsigned vl = (unsigned)lane * 16u;
    const float* WS_ = (const float*)ap->in[I_CWS]; const float* BS = (const float*)ap->in[I_CBS];
    { const float* LG = (const float*)ap->in[I_CLNG]; const float* LB = (const float*)ap->in[I_CLNB];
      for (int i = F.tid; i < SH; i += NWAVES * 64) { LGs[i] = LG[i]; LBs[i] = LB[i]; } }
    const int NP = NCHUNK * 4, PP = (NP + F.G - 1) / F.G, p0 = F.vcu * PP, p1 = (p0 + PP < NP) ? p0 + PP : NP;
    int nprev = -1;
    for (int p = p0; p < p1; ++p) {
        const int g = p & 3, n = p >> 2;
        const int t = 16 * w + l15, nk = (w >> 1) + 1;
        asm volatile("s_waitcnt lgkmcnt(0)" ::: "memory"); __builtin_amdgcn_s_barrier(); asm volatile("" ::: "memory");
        sgu_dma(VB, (const char*)VT + ((size_t)n * SH + g * SGD) * (CH * 2), w, vl);
        u32x2 upre[16];
#pragma unroll
        for (int db = 0; db < 16; ++db) upre[db] = *(const u32x2*)(U + (size_t)(n * CH + t) * SH + g * SGD + db * 16 + 4 * q);
        if (n != nprev) {
            float ssum = 0.f, ssq = 0.f;
            if (F.tid < CH) { const f32x2* sp = ST + (size_t)(n * CH + F.tid) * 48;
#pragma unroll 8
                for (int j = 0; j < 48; ++j) { const f32x2 x = sp[j]; ssum += x.x; ssq += x.y; }
                const float mean = ssum * (1.0f / SH), var = ssq * (1.0f / SH) - mean * mean; MU[F.tid] = mean; RS[F.tid] = __builtin_amdgcn_rsqf(var + LN_EPS); }
            nprev = n;
        }
        const float* wrow = WS_ + ((size_t)g * CH + t) * CH;
        f32x4 wv[4][2];
#pragma unroll
        for (int kp = 0; kp < 4; ++kp) { if (kp < nk) { wv[kp][0] = *(const f32x4*)(wrow + 32 * kp + 8 * q); wv[kp][1] = *(const f32x4*)(wrow + 32 * kp + 8 * q + 4); } else { wv[kp][0] = wv[kp][1] = (f32x4){0.f, 0.f, 0.f, 0.f}; } }
        const float bs = BS[g * CH + t];
        asm volatile("s_waitcnt vmcnt(0) lgkmcnt(0)" ::: "memory"); __builtin_amdgcn_s_barrier(); asm volatile("" ::: "memory");
        bf16x8 af[4]; float c1 = 0.f, c2 = 0.f;
#pragma unroll
        for (int kp = 0; kp < 4; ++kp) {
            f32x4 v0 = {0.f, 0.f, 0.f, 0.f}, v1 = {0.f, 0.f, 0.f, 0.f};
            if (kp < nk) {
                const int s0 = 32 * kp + 8 * q; const f32x4 w0 = wv[kp][0], w1 = wv[kp][1];
#pragma unroll
                for (int j = 0; j < 4; ++j) {
                    if (s0 + j <= t) { c2 += w0[j]; v0[j] = bfr(w0[j] * RS[s0 + j]); c1 += v0[j] * MU[s0 + j]; }
                    if (s0 + 4 + j <= t) { c2 += w1[j]; v1[j] = bfr(w1[j] * RS[s0 + 4 + j]); c1 += v1[j] * MU[s0 + 4 + j]; }
                }
            }
            af[kp] = mk_frag(v0, v1);
        }
        c1 += shx(c1, 16, lane); c1 += shx(c1, 32, lane); c2 += shx(c2, 16, lane); c2 += shx(c2, 32, lane);
#pragma unroll
        for (int dt = 0; dt < 3; ++dt) {
            const int dbase = g * SGD + dt * 256; LAS unsigned char* vb = VB + (dt & 1) * 65536;
            u32x2 unext[16];
            if (dt < 2) {
                sgu_dma(VB + ((dt + 1) & 1) * 65536, (const char*)VT + ((size_t)n * SH + dbase + 256) * (CH * 2), w, vl);
#pragma unroll
                for (int db = 0; db < 16; ++db) unext[db] = *(const u32x2*)(U + (size_t)(n * CH + t) * SH + dbase + 256 + db * 16 + 4 * q);
            }
#pragma unroll
            for (int db = 0; db < 16; ++db) {
                f32x4 acc = {0.f, 0.f, 0.f, 0.f};
#pragma unroll
                for (int kp = 0; kp < 4; ++kp) if (kp < nk) acc = MFMA16(*(const LAS bf16x8*)(vb + db * 4096 + kp * 1024 + vl), af[kp], acc);
                const int dg = dbase + db * 16 + 4 * q;
                const f32x4 lg = *(const LAS f32x4*)(LGs + dg), lb = *(const LAS f32x4*)(LBs + dg);
                bf16_t* up = U + (size_t)(n * CH + t) * SH + dg; const u32x2 uw = upre[db];
                const f32x4 uu = {bf_lo(uw.x), bf_hi(uw.x), bf_lo(uw.y), bf_hi(uw.y)};
                const f32x4 y = uu * (lg * (acc - c1) + lb * c2 + bs);
                u32x2 ov; ov.x = pk2(y[0], y[1]); ov.y = pk2(y[2], y[3]); if (!dry) *(u32x2*)up = ov;
            }
            if (dt < 2) {
                asm volatile("s_waitcnt vmcnt(0) lgkmcnt(0)" ::: "memory"); __builtin_amdgcn_s_barrier(); asm volatile("" ::: "memory");
#pragma unroll
                for (int db = 0; db < 16; ++db) upre[db] = unext[db];
            }
        }
    }
    asm volatile("s_waitcnt lgkmcnt(0)" ::: "memory"); __builtin_amdgcn_s_barrier(); asm volatile("" ::: "memory");
}

DI void grid_sync(CArgs* ap, int wv) {
    extern __shared__ __attribute__((aligned(16))) unsigned char lds[];
    XcdBarrier b; b.bar = (unsigned*)(ap->ws + WS_CTL) + CW_BAR; b.x = xb_xcc_id(); b.st = (volatile LAS unsigned*)((LAS unsigned char*)lds + MISC_OFF) + 8;
    int t = cur_tid(wv); asm volatile("" : "+v"(t));
    xcd_barrier(b, t == 0);
}
#ifndef PROBE_DRY
#define PROBE_DRY 0
#endif
#ifndef PROBE_EXTRA_BARRIERS
#define PROBE_EXTRA_BARRIERS 0
#endif
#ifndef PROBE_DUP_MASK
#define PROBE_DUP_MASK 0ull
#endif
#define PHASE(k, ...) do { const int ph_ = (k); for (int rep_ = 0; rep_ < (((PROBE_DUP_MASK >> (k)) & 1ull) ? 2 : 1); ++rep_) { CArgs* ap = kargs(); if (ap->ph_lo <= ph_ && ph_ < ap->ph_hi) { { Frame F = mkframe(ap, wv); unsigned char* ws = F.ws; unsigned char* R = ws + WS_R; (void)R; __VA_ARGS__ } \
        if (!MK_MULTI) { CArgs* ap2 = kargs(); if (ph_ + 1 < ap2->ph_hi) grid_sync(ap2, wv); } } } } while (0)
#ifndef PROBE_DUP_MASK_NB
#define PROBE_DUP_MASK_NB 0ull
#endif
#define PHASE_NB(k, ...) do { const int ph_ = (k); for (int rep_ = 0; rep_ < (((PROBE_DUP_MASK_NB >> (k)) & 1ull) ? 2 : 1); ++rep_) { CArgs* ap = kargs(); if (ap->ph_lo <= ph_ && ph_ < ap->ph_hi) { Frame F = mkframe(ap, wv); unsigned char* ws = F.ws; unsigned char* R = ws + WS_R; (void)R; __VA_ARGS__ } } } while (0)
#define XB_OF(L) ((bf16_t*)(ws + (((L) & 1) ? WS_XQ : WS_XP)))
#define X1_OF(L) ((bf16_t*)(ws + (((L) & 1) ? WS_XP : WS_XQ)))

template <int L> DI void layer_body(const int wv) {
        constexpr int mixer = L % 3, pb = 1 + L * 10;
        if constexpr (mixer == 0) {
            PHASE(pb + 0, { const int slot = L / 3;
              pg8::Gemm g{XB_OF(L), (const bf16_t*)(ws + WS_WAIN) + (size_t)slot * 3072 * D, M, 3072, D}; pg8::StaticOrder S; S.init(M, 3072, F.G, F.bx);
              pg8::EpiAin E{(bf16_t*)(R + R_BG), (bf16_t*)(R + R_Z)};
              pg8::gemm_phase<pg8::EpiAin, pg8::StaticOrder, false>(F.lds + RING_OFF, g, S, E, F.tid); });
            PHASE(pb + 1, { const int slot = L / 3; phase_conv(F, (const bf16_t*)(R + R_BG), (const bf16_t*)(R + R_Z), (const float*)ap->in[I_ACONV] + (size_t)slot * 3 * D, (bf16_t*)(R + R_YC)); });
        } else if constexpr (mixer == 1) {
            PHASE(pb + 0, {
              pg8::Gemm g{XB_OF(L), (const bf16_t*)(ws + WS_WBIN), M, 6144, D}; pg8::StaticOrder S; S.init(M, 6144, F.G, F.bx);
              pg8::EpiBin E{(bf16_t*)(R + R_QP), (bf16_t*)(R + R_KP), (bf16_t*)(R + R_KT), (bf16_t*)(R + R_VT), (bf16_t*)(R + R_GS), (const float*)(ws + WS_COS), (const float*)(ws + WS_SIN), F.lds + XPOSE_OFF};
              pg8::gemm_phase<pg8::EpiBin, pg8::StaticOrder, false>(F.lds + RING_OFF, g, S, E, F.tid); });
            PHASE(pb + 1, phase_ret_scan(F, (const bf16_t*)(R + R_QP), (const bf16_t*)(R + R_KT), (const bf16_t*)(R + R_VT), (bf16_t*)(R + R_CR), (bf16_t*)(ws + WS_S1)););
            if (PROBE_DRY & 1) PHASE(pb + 2, phase_ret_intra(F, (const bf16_t*)(R + R_QP), (const bf16_t*)(R + R_KP), (const bf16_t*)(R + R_VT), (const bf16_t*)(R + R_CR), (const bf16_t*)(ws + WS_S1), (bf16_t*)(R + R_GS), ap->ph_hi < 1000););
            PHASE(pb + 2, phase_ret_intra(F, (const bf16_t*)(R + R_QP), (const bf16_t*)(R + R_KP), (const bf16_t*)(R + R_VT), (const bf16_t*)(R + R_CR), (const bf16_t*)(ws + WS_S1), (bf16_t*)(R + R_GS), false););
        } else {
            PHASE(pb + 0, {
              pg8::Gemm g{XB_OF(L), (const bf16_t*)(ws + WS_WCIN), M, 6144, D}; pg8::StaticOrder S; S.init(M, 6144, F.G, F.bx);
              pg8::EpiCin E{(bf16_t*)(R + R_U), (bf16_t*)(R + R_CVT), (f32x2*)(R + R_ST), F.lds + XPOSE_OFF};
              pg8::gemm_phase<pg8::EpiCin, pg8::StaticOrder, false>(F.lds + RING_OFF, g, S, E, F.tid); });
            if (PROBE_DRY & 2) PHASE(pb + 1, phase_sgu(F, ap, (bf16_t*)(R + R_U), (const bf16_t*)(R + R_CVT), (const f32x2*)(R + R_ST), ap->ph_hi < 1000););
            PHASE(pb + 1, phase_sgu(F, ap, (bf16_t*)(R + R_U), (const bf16_t*)(R + R_CVT), (const f32x2*)(R + R_ST), false););
        }
        PHASE(pb + 3, { const int mx = L % 3, slot = L / 3;
          const bf16_t* WoA = (const bf16_t*)(R + (mx == 0 ? R_YC : mx == 1 ? R_GS : R_U));
          const bf16_t* WoB = mx == 0 ? (const bf16_t*)(ws + WS_WAOUT) + (size_t)slot * D * D : mx == 1 ? (const bf16_t*)(ws + WS_WBOUT) : (const bf16_t*)(ws + WS_WCOUT);
          const int WoK = mx == 0 ? D : mx == 1 ? VD : SH;
          pg8::Gemm g{WoA, WoB, M, D, WoK}; pg8::StaticOrder S; S.init(M, D, F.G, F.bx);
          pg8::EpiS1 E{XB_OF(L), (bf16_t*)(ws + WS_S1)};
          pg8::gemm_phase<pg8::EpiS1, pg8::StaticOrder, false>(F.lds + RING_OFF, g, S, E, F.tid); });
        if ((PROBE_DRY & 4) && L == 0) PHASE(pb + 4, phase_ln1_route(F, ap, L, (const bf16_t*)(ws + WS_S1), X1_OF(L), ap->ph_hi < 1000, R + R_X2););
        PHASE(pb + 4, phase_ln1_route(F, ap, L, (const bf16_t*)(ws + WS_S1), X1_OF(L), false, R + R_X2););
#define MOE_SCHED(S, LISTP, ESTR) pg8::MoeOrder S; S.tab = (const LAS int*)(F.lds + TAB_OFF); S.G = F.G; S.c = F.vcu; S.list = (LISTP); S.nN = 4; S.nshift = 2; S.estride = (ESTR); S.rdy = nullptr; S.apitch = 2048u; \
          const int total_ = S.tab[16] * 4, U1_ = total_ < 2 * F.G ? total_ : 2 * F.G, n1_ = total_ - U1_; (void)n1_;
        PHASE_NB(pb + 5, { moe_table(F, L);
          const bool f8 = (F.G * NWAVES == 2048);
          const float* RSC = (const float*)((const int*)(ws + WS_ROUTE) + 6 * M + 16 * M); const float* CSC = (const float*)(ws + WS_WGU + 16 * MiB);
          if (f8) { pg8::Gemm g{(const bf16_t*)(R + R_X2), (const bf16_t*)(ws + WS_WGU), NSLOT, 1024, D / 2};
            MOE_SCHED(S, (const int*)(ws + WS_ROUTE) + 6 * M, (size_t)1024 * D); S.apitch = 1024u; S.range(0, U1_, 0, 0);
            pg8::EpiMoe1 E{(bf16_t*)(R + R_H), F.ctl + CW_RDY + L * 256, F.ctl + CW_AGG + (L * 2) * 1024, xb_xcc_id(), MK_MULTI ? 0u : ((volatile LAS unsigned*)(F.lds + MISC_OFF))[8], RSC, CSC, (const LAS int*)(F.lds + TAB_OFF)};
            pg8::gemm_phase<pg8::EpiMoe1, pg8::MoeOrder, true, true>(F.lds + RING_OFF, g, S, E, F.tid);
          } else { pg8::Gemm g{X1_OF(L), (const bf16_t*)(ws + WS_WGU), NSLOT, 1024, D};
            MOE_SCHED(S, (const int*)(ws + WS_ROUTE) + 6 * M, (size_t)1024 * D * 2); S.range(0, U1_, 0, 0);
            pg8::EpiMoe1 E{(bf16_t*)(R + R_H), F.ctl + CW_RDY + L * 256, F.ctl + CW_AGG + (L * 2) * 1024, xb_xcc_id(), MK_MULTI ? 0u : ((volatile LAS unsigned*)(F.lds + MISC_OFF))[8], nullptr, nullptr, nullptr};
            pg8::gemm_phase<pg8::EpiMoe1, pg8::MoeOrder, true>(F.lds + RING_OFF, g, S, E, F.tid); } });
        PHASE_NB(pb + 6, { if (MK_MULTI) moe_table(F, L);
          const bool f8 = (F.G * NWAVES == 2048);
          const float* RSC = (const float*)((const int*)(ws + WS_ROUTE) + 6 * M + 16 * M); const float* CSC = (const float*)(ws + WS_WGU + 16 * MiB);
          if (f8) { pg8::Gemm g{(const bf16_t*)(R + R_X2), (const bf16_t*)(ws + WS_WGU), NSLOT, 1024, D / 2};
            MOE_SCHED(S, (const int*)(ws + WS_ROUTE) + 6 * M, (size_t)1024 * D); S.apitch = 1024u; S.c = moe_c2(F, n1_); S.range(U1_, total_, 0, 0);
            pg8::EpiMoe1 E{(bf16_t*)(R + R_H), F.ctl + CW_RDY + L * 256, nullptr, 0u, 0u, RSC, CSC, (const LAS int*)(F.lds + TAB_OFF)};
            pg8::gemm_phase<pg8::EpiMoe1, pg8::MoeOrder, true, true>(F.lds + RING_OFF, g, S, E, F.tid);
          } else { pg8::Gemm g{X1_OF(L), (const bf16_t*)(ws + WS_WGU), NSLOT, 1024, D};
            MOE_SCHED(S, (const int*)(ws + WS_ROUTE) + 6 * M, (size_t)1024 * D * 2); S.c = moe_c2(F, n1_); S.range(U1_, total_, 0, 0);
            pg8::EpiMoe1 E{(bf16_t*)(R + R_H), F.ctl + CW_RDY + L * 256, nullptr, 0u, 0u, nullptr, nullptr, nullptr};
            pg8::gemm_phase<pg8::EpiMoe1, pg8::MoeOrder, true>(F.lds + RING_OFF, g, S, E, F.tid); } });
        PHASE_NB(pb + 6, {
          const bool f8 = (F.G * NWAVES == 2048); const float* CSD = (const float*)(ws + WS_WDN + 8 * MiB);
          pg8::Gemm g{(const bf16_t*)(R + R_H), (const bf16_t*)(ws + WS_WDN), NSLOT, D, f8 ? DE / 2 : DE};
          MOE_SCHED(S, nullptr, f8 ? (size_t)D * DE : (size_t)D * DE * 2); S.rdy = F.ctl + CW_RDY + L * 256; S.c = moe_c2(F, n1_); const int U2_ = (n1_ < F.G && 2 * (F.G - n1_) < U1_) ? 2 * (F.G - n1_) : U1_; S.range(0, U2_, n1_, 1);
          pg8::EpiPlain E{(bf16_t*)(R + R_YS), D, f8 ? CSD : nullptr, 1.0f / H8S};
          if (f8) pg8::gemm_phase<pg8::EpiPlain, pg8::MoeOrder, false, true>(F.lds + RING_OFF, g, S, E, F.tid);
          else pg8::gemm_phase<pg8::EpiPlain, pg8::MoeOrder, false>(F.lds + RING_OFF, g, S, E, F.tid); });
        PHASE_NB(pb + 7, { if (MK_MULTI) moe_table(F, L);
          const bool f8 = (F.G * NWAVES == 2048); const float* CSD = (const float*)(ws + WS_WDN + 8 * MiB);
          pg8::Gemm g{(const bf16_t*)(R + R_H), (const bf16_t*)(ws + WS_WDN), NSLOT, D, f8 ? DE / 2 : DE};
          MOE_SCHED(S, nullptr, f8 ? (size_t)D * DE : (size_t)D * DE * 2); S.rdy = F.ctl + CW_RDY + L * 256; S.c = moe_c2(F, n1_); const int U2_ = (n1_ < F.G && 2 * (F.G - n1_) < U1_) ? 2 * (F.G - n1_) : U1_; S.range(U2_, total_, 0, 0);
          pg8::EpiPlain E{(bf16_t*)(R + R_YS), D, f8 ? CSD : nullptr, 1.0f / H8S};
          if (f8) pg8::gemm_phase<pg8::EpiPlain, pg8::MoeOrder, false, true>(F.lds + RING_OFF, g, S, E, F.tid);
          else pg8::gemm_phase<pg8::EpiPlain, pg8::MoeOrder, false>(F.lds + RING_OFF, g, S, E, F.tid); });
        PHASE(pb + 7, {
          const LAS int* tabp = (const LAS int*)(F.lds + TAB_OFF); const int total_ = tabp[16] * 4, U1_ = total_ < 2 * F.G ? total_ : 2 * F.G, n1_ = total_ - U1_;
          pg8::Gemm g{(const bf16_t*)(ws + WS_PB), (const bf16_t*)(ws + WS_WPROJ) + (size_t)L * D * PLE, M, D, PLE}; const int U2_ = (n1_ < F.G && 2 * (F.G - n1_) < U1_) ? 2 * (F.G - n1_) : U1_; pg8::SkipOrder S; S.init2(M, D, F.G, moe_c2(F, n1_), total_ - U2_);
          pg8::EpiPlain E{(bf16_t*)(R + R_EMB), D, nullptr, 1.0f};
          pg8::gemm_phase<pg8::EpiPlain, pg8::SkipOrder, false>(F.lds + RING_OFF, g, S, E, F.tid); });
        PHASE(pb + 8, { if (MK_MULTI) moe_table(F, L); phase_ln2(F, ap, L, X1_OF(L), (const bf16_t*)(R + R_YS), (bf16_t*)(R + R_X2), R + R_X2Q, (float*)(R + R_XS), R + R_WGQ, (float*)(R + R_CS)); });
        PHASE(pb + 9, {
          pg8::Gemm g{(const bf16_t*)(R + R_X2Q), (const bf16_t*)(R + R_WGQ), M, D, D / 2}; pg8::StaticOrder S; S.init(M, D, F.G, F.bx);
          pg8::EpiPle E{(const bf16_t*)(R + R_X2), (const bf16_t*)(R + R_EMB), (const float*)ap->in[I_PBG] + (size_t)L * D, X1_OF(L), ap->out, L == DEPTH - 1 ? 1 : 0, (const float*)(R + R_XS), (const float*)(R + R_CS)};
          pg8::gemm_phase<pg8::EpiPle, pg8::StaticOrder, false, true>(F.lds + RING_OFF, g, S, E, F.tid); });
}
__global__ void __launch_bounds__(NWAVES * 64, 2) mega_fwd(Args args) {
    extern __shared__ __attribute__((aligned(16))) unsigned char lds[];
    (void)args;
    const int wv = __builtin_amdgcn_readfirstlane((int)threadIdx.x >> 6);
    for (int u = threadIdx.x; u < (LDS_BYTES - LDSCTL_OFF) / 4; u += NWAVES * 64) ((LAS unsigned*)((LAS unsigned char*)lds + LDSCTL_OFF))[u] = 0u;
    __syncthreads();
    if (!MK_MULTI) { CArgs* ap = kargs(); (void)xcd_barrier_post((unsigned*)(ap->ws + WS_CTL) + CW_BAR, (volatile LAS unsigned*)((LAS unsigned char*)lds + MISC_OFF) + 8, threadIdx.x == 0); }

    PHASE(0, p0_prologue(F, ap););

    if (PROBE_EXTRA_BARRIERS) { for (int i = 0; i < PROBE_EXTRA_BARRIERS; ++i) { CArgs* apx = kargs(); grid_sync(apx, wv); } }
    layer_body<0>(wv); layer_body<1>(wv); layer_body<2>(wv); layer_body<3>(wv);
}
constexpr int NPHASES = 1 + DEPTH * 10;

extern "C" void kernel_launch(void* const* d_in, const int* in_sizes, int n_in, void* d_out, int out_size, void* d_ws, size_t ws_size, hipStream_t stream) {
    static int grid = 0;
    if (grid == 0) {
        if (n_in != 23 || out_size != M * D || ws_size < WS_END) { fprintf(stderr, "kernel_launch: unexpected problem (n_in %d, out %d, ws %zu)\n", n_in, out_size, ws_size); grid = -1; return; }
        int dev = 0, cus = 0, per_cu = 0;
        if (hipGetDevice(&dev) != hipSuccess || hipDeviceGetAttribute(&cus, hipDeviceAttributeMultiprocessorCount, dev) != hipSuccess) { grid = -1; return; }
        if (hipFuncSetAttribute((const void*)mega_fwd, hipFuncAttributeMaxDynamicSharedMemorySize, LDS_BYTES) != hipSuccess) { fprintf(stderr, "kernel_launch: hipFuncSetAttribute failed\n"); grid = -1; return; }
        if (hipOccupancyMaxActiveBlocksPerMultiprocessor(&per_cu, (const void*)mega_fwd, NWAVES * 64, LDS_BYTES) != hipSuccess || per_cu < 1) { fprintf(stderr, "kernel_launch: occupancy query says %d\n", per_cu); }
        (void)hipGetLastError();
        grid = cus;
    }
    if (grid < 0) return;
    (void)hipMemsetAsync((char*)d_ws + WS_CTL, 0, CTL_ZERO_BYTES, stream);
    Args a{};
    for (int i = 0; i < 23; ++i) a.in[i] = d_in[i];
    a.out = (float*)d_out; a.ws = (unsigned char*)d_ws;
#if MK_MULTI
    for (int p = 0; p < NPHASES; ++p) { a.ph_lo = p; a.ph_hi = p + 1; hipLaunchKernelGGL(mega_fwd, dim3(grid), dim3(NWAVES * 64), LDS_BYTES, stream, a); }
#else
    a.ph_lo = 0; a.ph_hi = NPHASES;
    hipLaunchKernelGGL(mega_fwd, dim3(grid), dim3(NWAVES * 64), LDS_BYTES, stream, a);
#endif
}
```

```cpp
#include <hip/hip_runtime.h>
#include <cstdio>
#include <cstdint>

#ifndef MK_MULTI
#define MK_MULTI 0
#endif

#define LAS __attribute__((address_space(3)))
#define GAS __attribute__((address_space(1)))
#define DI __device__ __forceinline__
typedef unsigned short bf16_t;
typedef short bf16x8 __attribute__((ext_vector_type(8)));
typedef float f32x4 __attribute__((ext_vector_type(4)));
typedef float f32x2 __attribute__((ext_vector_type(2)));
typedef unsigned u32x4 __attribute__((ext_vector_type(4)));
typedef unsigned u32x2 __attribute__((ext_vector_type(2)));
typedef __bf16 bf16x2v __attribute__((ext_vector_type(2)));

constexpr int NB = 2, SEQ = 8192, M = NB * SEQ, D = 1024, DEPTH = 4;
constexpr int CH = 128, NCHUNK = M / CH;
constexpr int RH = 4, DK = 256, DV = 512, VD = 2048;
constexpr int SH = 3072, SGD = 768;
constexpr int NE = 16, DE = 512;
constexpr int PLE = 256;
constexpr float ALPHA = 1.6817928305074290f;
constexpr float LN_EPS = 1e-5f;
constexpr int MAXTILES = 144;
constexpr int NSLOT = MAXTILES * 256;

DI unsigned pk2(float lo, float hi) { f32x2 v = {lo, hi}; bf16x2v r = __builtin_convertvector(v, bf16x2v); return __builtin_bit_cast(unsigned, r); }
DI float bf_lo(unsigned w) { return __uint_as_float(w << 16); }
DI float bf_hi(unsigned w) { return __uint_as_float(w & 0xffff0000u); }
DI unsigned short bf1(float x) { return (unsigned short)(pk2(x, 0.f) & 0xffffu); }
DI float bfr(float x) { return bf_lo(pk2(x, 0.f)); }
DI u32x4 pk8(f32x4 a, f32x4 b) { u32x4 w; w.x = pk2(a[0], a[1]); w.y = pk2(a[2], a[3]); w.z = pk2(b[0], b[1]); w.w = pk2(b[2], b[3]); return w; }
DI void unpk8(u32x4 w, f32x4& a, f32x4& b) { a = (f32x4){bf_lo(w.x), bf_hi(w.x), bf_lo(w.y), bf_hi(w.y)}; b = (f32x4){bf_lo(w.z), bf_hi(w.z), bf_lo(w.w), bf_hi(w.w)}; }
DI size_t tl16(size_t r, int c, int cols) { return ((r >> 4) * (size_t)(cols >> 3) + (size_t)(c >> 3)) * 128 + (r & 15) * 8 + (c & 7); }
DI size_t tl16t(size_t chunk, int rows, int erow, int s) { return (chunk * rows + (size_t)(erow & ~15)) * 128 + (size_t)(s >> 3) * 128 + (erow & 15) * 8 + (s & 7); }
DI int sig32(int d) { return (d & ~31) + 16 * ((d >> 2) & 1) + 4 * ((d >> 3) & 3) + (d & 3); }
DI float sigmoidf_(float x) { return __builtin_amdgcn_rcpf(1.0f + __builtin_amdgcn_exp2f(x * -1.4426950408889634f)); }
DI float siluf_(float x) { return x * __builtin_amdgcn_rcpf(1.0f + __builtin_amdgcn_exp2f(x * -1.4426950408889634f)); }
DI float shx(float v, int mask, int lane) { return __builtin_bit_cast(float, __builtin_amdgcn_ds_bpermute((lane ^ mask) << 2, __builtin_bit_cast(int, v))); }
#define DPP_ADD(v, ctrl, rmask) v += __builtin_bit_cast(float, __builtin_amdgcn_update_dpp(0, __builtin_bit_cast(int, v), (ctrl), (rmask), 0xf, false))
DI float wave_sum(float v, int lane) {
    (void)lane;
    DPP_ADD(v, 0xB1, 0xf); DPP_ADD(v, 0x4E, 0xf);
    DPP_ADD(v, 0x141, 0xf); DPP_ADD(v, 0x140, 0xf);
    DPP_ADD(v, 0x142, 0xa); DPP_ADD(v, 0x143, 0xc);
    return __builtin_bit_cast(float, __builtin_amdgcn_readlane(__builtin_bit_cast(int, v), 63));
}
#define DPP_MAX(v, ctrl, rmask) v = __builtin_fmaxf(v, __builtin_bit_cast(float, __builtin_amdgcn_update_dpp(0, __builtin_bit_cast(int, v), (ctrl), (rmask), 0xf, false)))
DI float wave_max_pos(float v) {
    DPP_MAX(v, 0xB1, 0xf); DPP_MAX(v, 0x4E, 0xf); DPP_MAX(v, 0x141, 0xf); DPP_MAX(v, 0x140, 0xf); DPP_MAX(v, 0x142, 0xa); DPP_MAX(v, 0x143, 0xc);
    return __builtin_bit_cast(float, __builtin_amdgcn_readlane(__builtin_bit_cast(int, v), 63));
}
DI unsigned pk4_fp8(float a, float b, float c, float d) { int w = 0; w = __builtin_amdgcn_cvt_pk_fp8_f32(a, b, w, false); w = __builtin_amdgcn_cvt_pk_fp8_f32(c, d, w, true); return (unsigned)w; }
DI unsigned pk4_fp8c(float a, float b, float c, float d) { return pk4_fp8(__builtin_amdgcn_fmed3f(a, -448.f, 448.f), __builtin_amdgcn_fmed3f(b, -448.f, 448.f), __builtin_amdgcn_fmed3f(c, -448.f, 448.f), __builtin_amdgcn_fmed3f(d, -448.f, 448.f)); }
#define LDS_WAIT() asm volatile("s_waitcnt lgkmcnt(0)" ::: "memory")
#define VM_WAIT() asm volatile("s_waitcnt vmcnt(0)" ::: "memory")

constexpr float H8S = 8.0f;
DI unsigned pk4_fp8(float a, float b, float c, float d);
DI unsigned pk4_fp8c(float a, float b, float c, float d);
constexpr float YC8S = 1.0f;
namespace pg8 {
constexpr int BM = 256, BK = 64, HALF = 128, HTB = HALF * BK * 2, STAGE_BYTES = 8 * HTB, NXCD = 8, WGM = 8;
DI int lds_byte(int r, int c) { const int st = (r >> 4) * 2 + (c >> 5), rr = r & 15, cc = c & 31, ob = rr * 64 + cc * 2; return st * 1024 + (ob ^ (((ob >> 9) & 1) << 5)); }
DI void stage_rc(int b, int& R, int& C) { const int st = b / 1024, sb = b % 1024, swz = sb ^ (((sb >> 9) & 1) << 5); R = (st >> 1) * 16 + swz / 64; C = (st & 1) * 32 + (swz % 64) / 2; }
DI int perm32(int rho) { const int n = rho >> 4, i = rho & 15; return 8 * (i >> 2) + 4 * n + (i & 3); }

struct Unit { int pm, pn, e, li; };
struct Gemm { const bf16_t* A; const bf16_t* Bt; int M, N, K; };

struct StaticOrder {
    int nM, nN, nwg, G, c;
    DI void init(int M_, int N_, int G_, int c_) { nM = M_ / BM; nN = N_ / BM; nwg = nM * nN; G = G_; c = c_; }
    DI bool next(int i, Unit& u) const {
        const long L = (long)i * G + c; if (L >= nwg) return false;
        int wgid = (int)L; { const int q = nwg / NXCD, r = nwg % NXCD, xcd = wgid % NXCD, off = wgid / NXCD; wgid = (xcd < r ? xcd * (q + 1) : r * (q + 1) + (xcd - r) * q) + off; }
        const int nig = WGM * nN, gid = wgid / nig, fm = gid * WGM, gsz = (nM - fm) < WGM ? (nM - fm) : WGM;
        u.pm = fm + ((wgid % nig) % gsz); u.pn = (wgid % nig) / gsz; u.e = 0; u.li = 0; return true;
    }
    DI const char* b_tile(const Gemm& g, const Unit& u) const { return (const char*)g.Bt + (size_t)u.pn * ((size_t)BM * g.K * 2); }
    DI unsigned a_rowoff(const Unit&, int) const { return 0u; }
};
struct MoeOrder {
    const LAS int* tab; int G, c; const int* list; int nN, nshift;
    size_t estride;
    int ulo, uhi, n1, mode;
    unsigned* rdy;
    DI void range(int lo, int hi, int n1_, int mode_) { ulo = lo; uhi = hi < lo ? lo : hi; n1 = n1_; mode = mode_; }
    DI bool next(int i, Unit& u) const {
        int L;
        if (mode == 0 || n1 >= G) L = ulo + i * G + c;
        else if (c < n1) return false;
        else L = ulo + i * (G - n1) + (c - n1);
        if (L >= uhi) return false;
        const int rt = L >> nshift; u.pn = L & (nN - 1); u.pm = rt; int e = 0;
#pragma unroll
        for (int j = 1; j < 16; ++j) e += (rt >= tab[j]) ? 1 : 0;
        u.e = e; u.li = rt - tab[e];
        if (rdy) {
            unsigned sp = 0;
            while (__hip_atomic_load(rdy + rt, __ATOMIC_RELAXED, __HIP_MEMORY_SCOPE_AGENT) < (unsigned)nN) { __builtin_amdgcn_s_sleep(1); if (++sp > (1u << 22)) break; }
            asm volatile("" ::: "memory");
        }
        return true;
    }
    DI const char* b_tile(const Gemm& g, const Unit& u) const { return (const char*)g.Bt + (size_t)u.e * estride + (size_t)u.pn * ((size_t)BM * g.K * 2); }
    unsigned apitch;
    DI unsigned a_rowoff(const Unit& u, int r) const { const int idx = u.li * 256 + r; const int tok = (idx < tab[32 + u.e]) ? list[u.e * M + idx] : 0; return (unsigned)tok * apitch; }
};
struct SkipOrder : StaticOrder {
    DI void init2(int M_, int N_, int G_, int c_, int skip) { if (skip >= G_) skip = 0; StaticOrder::init(M_, N_, G_ - skip, c_ - skip); neg = (c_ < skip); }
    bool neg;
    DI bool next(int i, Unit& u) const { if (neg) return false; return StaticOrder::next(i, u); }
};

typedef f32x4 Acc[2][2][4][2];

DI f32x2 gelu_pk(f32x2 v) {
    const f32x2 av = __builtin_elementwise_abs(v), d = av * 0.2316418882f + 1.0f;
    f32x2 t; t.x = __builtin_amdgcn_rcpf(d.x); t.y = __builtin_amdgcn_rcpf(d.y);
    f32x2 q = t * 0.5307027145f + (-0.7265760135f); q = q * t + 0.7107068705f; q = q * t + (-0.142248368f); q = q * t + 0.127414796f; q = q * t;
    const f32x2 s = (v * v) * (-0.72134752044f);
    f32x2 e; e.x = __builtin_amdgcn_exp2f(s.x); e.y = __builtin_amdgcn_exp2f(s.y);
    const f32x2 m = v * (q * e), r = v - m;
    f32x2 o; o.x = v.x < 0.f ? m.x : r.x; o.y = v.y < 0.f ? m.y : r.y; return o;
}
DI f32x4 gelu4(f32x4 v) { const f32x2 a = gelu_pk((f32x2){v[0], v[1]}), b = gelu_pk((f32x2){v[2], v[3]}); return (f32x4){a.x, a.y, b.x, b.y}; }

DI u32x4 rowmajor16(u32x4 w, int fr, int fq) {
    const int l = fq * 16 + fr, src = (16 * (l & 3) + (l >> 2)) << 2; u32x4 o;
    o.x = (unsigned)__builtin_amdgcn_ds_bpermute(src, (int)w.x); o.y = (unsigned)__builtin_amdgcn_ds_bpermute(src, (int)w.y);
    o.z = (unsigned)__builtin_amdgcn_ds_bpermute(src, (int)w.z); o.w = (unsigned)__builtin_amdgcn_ds_bpermute(src, (int)w.w); return o;
}
DI u32x2 rowmajor8(u32x2 w, int fr, int fq) {
    const int l = fq * 16 + fr, src = (16 * (l & 3) + (l >> 2)) << 2; u32x2 o;
    o.x = (unsigned)__builtin_amdgcn_ds_bpermute(src, (int)w.x); o.y = (unsigned)__builtin_amdgcn_ds_bpermute(src, (int)w.y); return o;
}
template <bool PERMK>
DI void tgroup_lds(LAS unsigned char* xlds, const u32x4 w0, const u32x4 w1, int fr, int fq, u32x4 (&out)[2]) {
    const unsigned a0[4] = {w0.x, w0.y, w0.z, w0.w}, a1[4] = {w1.x, w1.y, w1.z, w1.w};
#pragma unroll
    for (int j = 0; j < 8; ++j) {
        const int lf = 8 * fq + j, lr = PERMK ? (16 * ((j >> 2) & 1) + 4 * fq + (j & 3)) : lf;
        const unsigned short v0 = (unsigned short)((j & 1) ? (a0[j >> 1] >> 16) : (a0[j >> 1] & 0xffffu)), v1 = (unsigned short)((j & 1) ? (a1[j >> 1] >> 16) : (a1[j >> 1] & 0xffffu));
        *(LAS unsigned short*)(xlds + lr * 48 + fr * 2) = v0; *(LAS unsigned short*)(xlds + (32 + lr) * 48 + fr * 2) = v1;
    }
    LDS_WAIT(); asm volatile("" ::: "memory");
    const int lane = fq * 16 + fr;
    out[0] = *(const LAS u32x4*)(xlds + lane * 48); out[1] = *(const LAS u32x4*)(xlds + lane * 48 + 16);
    LDS_WAIT(); asm volatile("" ::: "memory");
}
struct EpiAin {
    static constexpr bool PERM = true;
    bf16_t* BG; bf16_t* Z;
    DI void operator()(const Acc& acc, const Unit& u, int wr, int wc, int fr, int fq) const {
        const int l = fq * 16 + fr, pfr = l >> 2, pfq = l & 3;
        const int row0 = u.pm * BM + wr * 64 + pfr, cw = wc * 32 + 8 * pfq;
        if (u.pn < 4) {
#pragma unroll
            for (int ai = 0; ai < 2; ++ai)
#pragma unroll
                for (int m = 0; m < 4; ++m) { bf16_t* rowp = BG + (size_t)(row0 + ai * HALF + m * 16) * D + u.pn * 256 + cw;
#pragma unroll
                    for (int bj = 0; bj < 2; ++bj) *(u32x4*)(rowp + bj * HALF) = rowmajor16(pk8(acc[ai][bj][m][0], acc[ai][bj][m][1]), fr, fq); }
        } else {
#pragma unroll
            for (int ai = 0; ai < 2; ++ai)
#pragma unroll
                for (int m = 0; m < 4; ++m) { bf16_t* rowp = Z + (size_t)(row0 + ai * HALF + m * 16) * D + (u.pn - 4) * 128 + cw;
                    *(u32x4*)rowp = rowmajor16(pk8(acc[ai][0][m][0] * acc[ai][1][m][0], acc[ai][0][m][1] * acc[ai][1][m][1]), fr, fq); }
        }
    }
};
struct EpiS1 {
    static constexpr bool PERM = true;
    const bf16_t* X; bf16_t* S1; const float* CS; float sc;
    DI void operator()(const Acc& acc, const Unit& u, int wr, int wc, int fr, int fq) const {
        const int row0 = u.pm * BM + wr * 64 + fr, cw = u.pn * 256 + wc * 32 + 8 * fq;
        f32x4 cs[2][2];
#pragma unroll
        for (int bj = 0; bj < 2; ++bj) { cs[bj][0] = CS ? *(const f32x4*)(CS + cw + bj * HALF) * sc : (f32x4){1.f, 1.f, 1.f, 1.f}; cs[bj][1] = CS ? *(const f32x4*)(CS + cw + bj * HALF + 4) * sc : (f32x4){1.f, 1.f, 1.f, 1.f}; }
        u32x4 xr[2][4][2];
#pragma unroll
        for (int ai = 0; ai < 2; ++ai)
#pragma unroll
            for (int m = 0; m < 4; ++m)
#pragma unroll
                for (int bj = 0; bj < 2; ++bj) xr[ai][m][bj] = *(const u32x4*)(X + (size_t)(row0 + ai * HALF + m * 16) * D + cw + bj * HALF);
#pragma unroll
        for (int ai = 0; ai < 2; ++ai)
#pragma unroll
            for (int m = 0; m < 4; ++m) { const size_t off = (size_t)(row0 + ai * HALF + m * 16) * D + cw;
#pragma unroll
                for (int bj = 0; bj < 2; ++bj) { f32x4 x0, x1; unpk8(xr[ai][m][bj], x0, x1);
                    *(u32x4*)(S1 + off + bj * HALF) = pk8(x0 * ALPHA + acc[ai][bj][m][0] * cs[bj][0], x1 * ALPHA + acc[ai][bj][m][1] * cs[bj][1]); } }
    }
};
struct EpiBin {
    static constexpr bool PERM = true;
    bf16_t *QP, *KP, *KT, *VT, *GS; const float *COS, *SIN; LAS unsigned char* xbase;
    DI void operator()(const Acc& acc, const Unit& u, int wr, int wc, int fr, int fq) const {
        const int row0 = u.pm * BM + wr * 64 + fr, cw = wc * 32 + 8 * fq, pn = u.pn; LAS unsigned char* xlds = xbase + (wr * 4 + wc) * 3072;
        u32x4 tv[4][2], kw[4][2];
        if (pn < 8) {
            const bool isk = pn >= 4; const int h = pn & 3;
            const float lg2 = __log2f(1.0f - __builtin_amdgcn_exp2f(-5.0f - (float)h));
            bf16_t* dst = isk ? KP : QP;
#pragma unroll
            for (int ai = 0; ai < 2; ++ai) {
                f32x4 csn[4][4];
#pragma unroll
                for (int m = 0; m < 4; ++m) { const int pos_ = (row0 + ai * HALF + m * 16) & (SEQ - 1);
                    csn[m][0] = *(const f32x4*)(COS + (size_t)pos_ * 128 + cw); csn[m][1] = *(const f32x4*)(COS + (size_t)pos_ * 128 + cw + 4);
                    csn[m][2] = *(const f32x4*)(SIN + (size_t)pos_ * 128 + cw); csn[m][3] = *(const f32x4*)(SIN + (size_t)pos_ * 128 + cw + 4); }
#pragma unroll
                for (int m = 0; m < 4; ++m) {
                    const int row = row0 + ai * HALF + m * 16, c = row & (CH - 1);
                    const float scale = isk ? __builtin_amdgcn_exp2f(-(float)c * lg2) * 0.0625f : __builtin_amdgcn_exp2f((float)c * lg2);
                    const f32x4 cs0 = csn[m][0], cs1 = csn[m][1], sn0 = csn[m][2], sn1 = csn[m][3];
                    const f32x4 a0 = acc[ai][0][m][0], a1 = acc[ai][0][m][1], b0 = acc[ai][1][m][0], b1 = acc[ai][1][m][1];
                    const f32x4 o10 = (a0 * cs0 - b0 * sn0) * scale, o11 = (a1 * cs1 - b1 * sn1) * scale;
                    const f32x4 o20 = (b0 * cs0 + a0 * sn0) * scale, o21 = (b1 * cs1 + a1 * sn1) * scale;
                    const u32x4 w1 = pk8(o10, o11), w2 = pk8(o20, o21);
                    if (!isk) { *(u32x4*)(dst + tl16((size_t)row, h * 256 + cw, D)) = w1; *(u32x4*)(dst + tl16((size_t)row, h * 256 + 128 + cw, D)) = w2; }
                    else { kw[m][0] = w1; kw[m][1] = w2; tgroup_lds<true>(xlds, w1, w2, fr, fq, tv[m]); }
                }
              if (isk) {
                const int ln = fq * 16 + fr, er = h * 256 + (ln < 32 ? 0 : 128) + wc * 32 + (ln & 31);
#pragma unroll
                for (int m = 0; m < 4; ++m) { const size_t srow = (size_t)sig32(row0 + ai * HALF + m * 16);
                    *(u32x4*)(dst + tl16(srow, h * 256 + cw, D)) = kw[m][0]; *(u32x4*)(dst + tl16(srow, h * 256 + 128 + cw, D)) = kw[m][1]; }
#pragma unroll
                for (int m = 0; m < 4; ++m) { const int rowg = u.pm * BM + wr * 64 + ai * HALF + m * 16;
#pragma unroll
                    for (int hh = 0; hh < 2; ++hh) *(u32x4*)(KT + tl16t((size_t)(rowg >> 7), D, er, (rowg & (CH - 1)) + 8 * hh)) = tv[m][hh]; }
              }
            }
        } else if (pn < 16) {
#pragma unroll
            for (int ai = 0; ai < 2; ++ai) {
#pragma unroll
                for (int m = 0; m < 4; ++m) tgroup_lds<false>(xlds, pk8(acc[ai][0][m][0], acc[ai][0][m][1]), pk8(acc[ai][1][m][0], acc[ai][1][m][1]), fr, fq, tv[m]);
                const int ln = fq * 16 + fr, er = (pn - 8) * 256 + (ln < 32 ? 0 : HALF) + wc * 32 + (ln & 31);
#pragma unroll
                for (int m = 0; m < 4; ++m) { const int rowg = u.pm * BM + wr * 64 + ai * HALF + m * 16;
#pragma unroll
                    for (int hh = 0; hh < 2; ++hh) *(u32x4*)(VT + tl16t((size_t)(rowg >> 7), VD, er, (rowg & (CH - 1)) + 8 * hh)) = tv[m][hh]; }
            }
        } else {
#pragma unroll
            for (int ai = 0; ai < 2; ++ai)
#pragma unroll
                for (int m = 0; m < 4; ++m) { bf16_t* rowp = GS + (size_t)(row0 + ai * HALF + m * 16) * VD + (pn - 16) * 256 + cw;
#pragma unroll
                    for (int bj = 0; bj < 2; ++bj) { f32x4 v0 = acc[ai][bj][m][0], v1 = acc[ai][bj][m][1];
#pragma unroll
                        for (int j = 0; j < 4; ++j) { v0[j] = siluf_(v0[j]); v1[j] = siluf_(v1[j]); }
                        *(u32x4*)(rowp + bj * HALF) = pk8(v0, v1); } }
        }
    }
};
struct EpiCin {
    static constexpr bool PERM = true;
    bf16_t *U, *VT; f32x2* ST; LAS unsigned char* xbase;
    DI void operator()(const Acc& acc, const Unit& u, int wr, int wc, int fr, int fq) const {
        const int row0 = u.pm * BM + wr * 64 + fr, cw = wc * 32 + 8 * fq, pn = u.pn; LAS unsigned char* xlds = xbase + (wr * 4 + wc) * 3072; u32x4 tv[4][2]; f32x2 stv = {0.f, 0.f};
        if (pn < 12) {
#pragma unroll
            for (int ai = 0; ai < 2; ++ai)
#pragma unroll
                for (int m = 0; m < 4; ++m) { bf16_t* rowp = U + (size_t)(row0 + ai * HALF + m * 16) * SH + pn * 256 + cw;
#pragma unroll
                    for (int bj = 0; bj < 2; ++bj) *(u32x4*)(rowp + bj * HALF) = pk8(gelu4(acc[ai][bj][m][0]), gelu4(acc[ai][bj][m][1])); }
        } else {
#pragma unroll
            for (int ai = 0; ai < 2; ++ai) {
#pragma unroll
                for (int m = 0; m < 4; ++m) {
                    const int row = row0 + ai * HALF + m * 16; float s = 0.f, ss = 0.f;
                    u32x4 wv2[2];
#pragma unroll
                    for (int bj = 0; bj < 2; ++bj) {
                        const u32x4 w = pk8(gelu4(acc[ai][bj][m][0]), gelu4(acc[ai][bj][m][1])); const unsigned ww[4] = {w.x, w.y, w.z, w.w}; wv2[bj] = w;
#pragma unroll
                        for (int j = 0; j < 4; ++j) { const float lo = bf_lo(ww[j]), hi = bf_hi(ww[j]); s += lo + hi; ss += lo * lo + hi * hi; }
                    }
                    tgroup_lds<false>(xlds, wv2[0], wv2[1], fr, fq, tv[m]);
                    { const int ln = fq * 16 + fr; s += shx(s, 16, ln); s += shx(s, 32, ln); ss += shx(ss, 16, ln); ss += shx(ss, 32, ln); }
                    if (fq == m) stv = (f32x2){s, ss};
                }
                ST[(size_t)(row0 + ai * HALF + fq * 16) * 48 + (pn - 12) * 4 + wc] = stv;
                const int ln = fq * 16 + fr, er = (pn - 12) * 256 + (ln < 32 ? 0 : HALF) + wc * 32 + (ln & 31);
#pragma unroll
                for (int m = 0; m < 4; ++m) { const int rowg = u.pm * BM + wr * 64 + ai * HALF + m * 16;
#pragma unroll
                    for (int hh = 0; hh < 2; ++hh) *(u32x4*)(VT + tl16t((size_t)(rowg >> 7), SH, er, (rowg & (CH - 1)) + 8 * hh)) = tv[m][hh]; }
            }
        }
    }
};
struct EpiMoe1 {
    static constexpr bool PERM = true;
    static constexpr bool SIGNAL = true;
    bf16_t* H; unsigned* rdy; unsigned* agg; unsigned x, nloc; const float* RSC; const float* CSC; const LAS int* tabp;
    DI void operator()(const Acc& acc, const Unit& u, int wr, int wc, int fr, int fq) const {
        const int l = fq * 16 + fr, pfr = l >> 2, pfq = l & 3;
        const int row0 = u.pm * BM + wr * 64 + pfr, cw = u.pn * 128 + wc * 32 + 8 * pfq;
#pragma unroll
        for (int ai = 0; ai < 2; ++ai)
#pragma unroll
            for (int m = 0; m < 4; ++m) { f32x4 v0 = acc[ai][0][m][0], v1 = acc[ai][0][m][1], u0 = acc[ai][1][m][0], u1 = acc[ai][1][m][1];
                if (RSC) { const int idx = u.li * 256 + wr * 64 + ai * HALF + m * 16 + fr; const float xs = idx < tabp[32 + u.e] ? RSC[(size_t)u.e * M + idx] : 0.f;
                    const float* cg = CSC + (size_t)u.e * 1024 + u.pn * 256 + wc * 32 + 8 * fq;
                    v0 *= *(const f32x4*)cg * xs; v1 *= *(const f32x4*)(cg + 4) * xs; u0 *= *(const f32x4*)(cg + 128) * xs; u1 *= *(const f32x4*)(cg + 132) * xs; }
#pragma unroll
                for (int j = 0; j < 4; ++j) { v0[j] = siluf_(v0[j]) * u0[j]; v1[j] = siluf_(v1[j]) * u1[j]; }
                if (RSC) { u32x2 q; q.x = pk4_fp8c(v0[0] * H8S, v0[1] * H8S, v0[2] * H8S, v0[3] * H8S); q.y = pk4_fp8c(v1[0] * H8S, v1[1] * H8S, v1[2] * H8S, v1[3] * H8S);
                    *(u32x2*)((unsigned char*)H + (size_t)(row0 + ai * HALF + m * 16) * DE + cw) = rowmajor8(q, fr, fq); }
                else *(u32x4*)(H + (size_t)(row0 + ai * HALF + m * 16) * DE + cw) = rowmajor16(pk8(v0, v1), fr, fq); }
    }
};
struct EpiPlain {
    static constexpr bool PERM = true;
    bf16_t* O; int ld; const float* CS; float sc;
    DI void operator()(const Acc& acc, const Unit& u, int wr, int wc, int fr, int fq) const {
        const int l = fq * 16 + fr, pfr = l >> 2, pfq = l & 3;
        const int row0 = u.pm * BM + wr * 64 + pfr, cw = u.pn * 256 + wc * 32 + 8 * pfq;
        f32x4 cs[2][2];
#pragma unroll
        for (int bj = 0; bj < 2; ++bj) { const float* cp = CS ? CS + (size_t)u.e * 1024 + u.pn * 256 + bj * HALF + wc * 32 + 8 * fq : nullptr;
            cs[bj][0] = CS ? *(const f32x4*)cp * sc : (f32x4){1.f, 1.f, 1.f, 1.f}; cs[bj][1] = CS ? *(const f32x4*)(cp + 4) * sc : (f32x4){1.f, 1.f, 1.f, 1.f}; }
#pragma unroll
        for (int ai = 0; ai < 2; ++ai)
#pragma unroll
            for (int m = 0; m < 4; ++m) { bf16_t* rowp = O + (size_t)(row0 + ai * HALF + m * 16) * ld + cw;
#pragma unroll
                for (int bj = 0; bj < 2; ++bj) *(u32x4*)(rowp + bj * HALF) = rowmajor16(pk8(acc[ai][bj][m][0] * cs[bj][0], acc[ai][bj][m][1] * cs[bj][1]), fr, fq); }
    }
};
struct EpiPle {
    static constexpr bool PERM = true;
    const bf16_t* X2; const bf16_t* EMB; const float* bias; bf16_t* XN; float* OUT; int last; const float* XS; const float* CS;
    DI void operator()(const Acc& acc, const Unit& u, int wr, int wc, int fr, int fq) const {
        const int row0 = u.pm * BM + wr * 64 + fr, cw = u.pn * 256 + wc * 32 + 8 * fq;
#pragma unroll
        for (int ai = 0; ai < 2; ++ai) {
            u32x4 xr[4][2], er[4][2]; float xs[4];
#pragma unroll
            for (int m = 0; m < 4; ++m) xs[m] = XS[row0 + ai * HALF + m * 16];
#pragma unroll
            for (int m = 0; m < 4; ++m)
#pragma unroll
                for (int bj = 0; bj < 2; ++bj) { const size_t o2 = (size_t)(row0 + ai * HALF + m * 16) * D + cw + bj * HALF; xr[m][bj] = *(const u32x4*)(X2 + o2); er[m][bj] = *(const u32x4*)(EMB + o2); }
#pragma unroll
            for (int bj = 0; bj < 2; ++bj) {
                const f32x4 b0 = *(const f32x4*)(bias + cw + bj * HALF), b1 = *(const f32x4*)(bias + cw + bj * HALF + 4);
                const f32x4 c0 = *(const f32x4*)(CS + cw + bj * HALF), c1 = *(const f32x4*)(CS + cw + bj * HALF + 4);
#pragma unroll
                for (int m = 0; m < 4; ++m) { const size_t off = (size_t)(row0 + ai * HALF + m * 16) * D + cw;
                    f32x4 x0, x1, e0, e1; unpk8(xr[m][bj], x0, x1); unpk8(er[m][bj], e0, e1);
                    f32x4 g0 = acc[ai][bj][m][0] * (c0 * xs[m]) + b0, g1 = acc[ai][bj][m][1] * (c1 * xs[m]) + b1;
#pragma unroll
                    for (int j = 0; j < 4; ++j) { g0[j] = x0[j] + sigmoidf_(g0[j]) * e0[j]; g1[j] = x1[j] + sigmoidf_(g1[j]) * e1[j]; }
                    if (last) { *(f32x4*)(OUT + off + bj * HALF) = g0; *(f32x4*)(OUT + off + bj * HALF + 4) = g1; }
                    else *(u32x4*)(XN + off + bj * HALF) = pk8(g0, g1);
                } }
        }
    }
};


template <class E, class = void> struct epi_signal { static constexpr bool value = false; };
template <class E> struct epi_signal<E, decltype((void)E::SIGNAL)> { static constexpr bool value = E::SIGNAL; };
typedef int i32x8 __attribute__((ext_vector_type(8)));
typedef int i32x4v __attribute__((ext_vector_type(4)));
template <class Epi, class Sched, bool GATHER, bool F8 = false>
DI void gemm_phase(LAS unsigned char* lds, const Gemm g, const Sched& S, const Epi& E, const int tid) {
    const int wid = __builtin_amdgcn_readfirstlane(tid >> 6), lane = tid & 63, wr = wid >> 2, wc = wid & 3, fr = lane & 15, fq = lane >> 4;
    int Kl = g.K; asm volatile("" : "+s"(Kl));
    const int K = Kl, nt = K / BK;
    unsigned voffA[2], voffB[2]; int RA[2], CA[2];
#pragma unroll
    for (int i = 0; i < 2; ++i) { int R, C; stage_rc(tid * 16 + i * 8192, R, C); const int Rb = Epi::PERM ? ((R & ~31) + perm32(R & 31)) : R;
        RA[i] = R; CA[i] = C; voffA[i] = (unsigned)(R * K + C) * 2u; voffB[i] = (unsigned)(Rb * K + C) * 2u; }
    const size_t kstep = (size_t)(BK * 2);
    const size_t hstep = (size_t)HALF * K * 2;
    const size_t tstep = 2 * hstep;
    const unsigned ldsw = (unsigned)wid * 1024u;
    const int aoff = lds_byte(wr * 64 + fr, fq * 8), boff = lds_byte(wc * 32 + fr, fq * 8);
#define PG8_SA(b, h) (((b) * 2 + (h)) * HTB)
#define PG8_SB(b, h) ((4 + (b) * 2 + (h)) * HTB)
#define PG8_STAGE(bufoff, gbase, voff) do { _Pragma("unroll") for (int _i = 0; _i < 2; ++_i) \
        __builtin_amdgcn_global_load_lds((const unsigned*)((const char*)(gbase) + (voff)[_i]), (LAS unsigned*)(lds + (bufoff) + ldsw + _i * 8192), 16, 0, 0); } while (0)
#define PG8_CAT8(p) __builtin_shufflevector(*(const LAS i32x4v*)(p), *(const LAS i32x4v*)((p) + 1024), 0, 1, 2, 3, 4, 5, 6, 7)
#define PG8_LDA(dst, b, h) do { _Pragma("unroll") for (int m = 0; m < 4; ++m) { if constexpr (F8) dst##8[m] = PG8_CAT8(lds + PG8_SA(b, h) + aoff + m * 2048); \
        else { _Pragma("unroll") for (int k = 0; k < 2; ++k) dst[m][k] = *(const LAS bf16x8*)(lds + PG8_SA(b, h) + aoff + m * 2048 + k * 1024); } } } while (0)
#define PG8_LDB(dst, b, h) do { _Pragma("unroll") for (int n = 0; n < 2; ++n) { if constexpr (F8) dst##8[n] = PG8_CAT8(lds + PG8_SB(b, h) + boff + n * 2048); \
        else { _Pragma("unroll") for (int k = 0; k < 2; ++k) dst[n][k] = *(const LAS bf16x8*)(lds + PG8_SB(b, h) + boff + n * 2048 + k * 1024); } } } while (0)
#define PG8_MMA(ai, bj, At, Bt) do { __builtin_amdgcn_s_setprio(1); _Pragma("unroll") for (int m = 0; m < 4; ++m) _Pragma("unroll") for (int n = 0; n < 2; ++n) { \
        if constexpr (F8) asm volatile("v_mfma_f32_16x16x128_f8f6f4 %0, %1, %2, %0" : "+v"(acc[ai][bj][m][n]) : "v"(Bt##8[n]), "v"(At##8[m]));        \
        else { _Pragma("unroll") for (int k = 0; k < 2; ++k) acc[ai][bj][m][n] = __builtin_amdgcn_mfma_f32_16x16x32_bf16(Bt[n][k], At[m][k], acc[ai][bj][m][n], 0, 0, 0); } } \
        __builtin_amdgcn_s_setprio(0); } while (0)
#define PG8_WAIT_V(n) asm volatile("s_waitcnt vmcnt(" #n ")" ::: "memory")
#define PG8_WAIT_L(n) asm volatile("s_waitcnt lgkmcnt(" #n ")" ::: "memory")
#define PG8_BAR __builtin_amdgcn_s_barrier()
#define PG8_SCHED __builtin_amdgcn_sched_barrier(0)
    Unit cur, nxt; int ui = 0, pend = -1; bool arrived = false; (void)pend; (void)arrived;
    if (!S.next(0, cur)) {
        if constexpr (epi_signal<Epi>::value) {
            if (wid == 0 && E.nloc != 0u) {
                unsigned last = 0u;
                if (lane == 0) { const unsigned old = __hip_atomic_fetch_add(E.agg + E.x * 16, 1u, __ATOMIC_RELAXED, __HIP_MEMORY_SCOPE_AGENT); last = (old + 1u == E.nloc) ? 1u : 0u; }
                last = (unsigned)__builtin_amdgcn_readfirstlane((int)last);
                if (last) {
                    __builtin_amdgcn_fence(__ATOMIC_RELEASE, "agent"); asm volatile("s_waitcnt vmcnt(0)" ::: "memory");
                    for (int i = lane; i < S.G; i += 64) {
                        const unsigned p = __hip_atomic_load(E.agg + 256 + i, __ATOMIC_RELAXED, __HIP_MEMORY_SCOPE_AGENT);
                        if ((p >> 24) == E.x + 1u) { (void)__hip_atomic_fetch_add(E.rdy + (p & 0xfffu) - 1u, 1u, __ATOMIC_RELAXED, __HIP_MEMORY_SCOPE_AGENT);
                            if ((p >> 12) & 0xfffu) (void)__hip_atomic_fetch_add(E.rdy + ((p >> 12) & 0xfffu) - 1u, 1u, __ATOMIC_RELAXED, __HIP_MEMORY_SCOPE_AGENT); }
                    }
                }
            }
        }
        return;
    }
    Acc acc;
#pragma unroll
    for (int a = 0; a < 2; ++a)
#pragma unroll
        for (int b = 0; b < 2; ++b)
#pragma unroll
            for (int m = 0; m < 4; ++m)
#pragma unroll
                for (int n = 0; n < 2; ++n) acc[a][b][m][n] = (f32x4){0.f, 0.f, 0.f, 0.f};
    bf16x8 At[4][2], B0[2][2], B1[2][2]; i32x8 At8[4], B08[2], B18[2]; (void)At; (void)B0; (void)B1; (void)At8; (void)B08; (void)B18;
    const char* cA = (const char*)g.A + (GATHER ? (size_t)0 : (size_t)cur.pm * tstep); const char* cB = S.b_tile(g, cur);
    unsigned gC[2][2], gN[2][2];
    if constexpr (GATHER) {
#pragma unroll
        for (int h = 0; h < 2; ++h)
#pragma unroll
            for (int i = 0; i < 2; ++i) { gC[h][i] = S.a_rowoff(cur, h * HALF + RA[i]) + (unsigned)CA[i] * 2u; gN[h][i] = gC[h][i]; }
    }
    if constexpr (GATHER) {
        PG8_STAGE(PG8_SB(0, 0), cB, voffB); PG8_STAGE(PG8_SB(0, 1), cB + hstep, voffB); PG8_STAGE(PG8_SA(0, 0), cA, gC[0]); PG8_STAGE(PG8_SA(0, 1), cA, gC[1]);
        if (wr == 1) PG8_BAR;
        PG8_WAIT_V(2); PG8_BAR;
        PG8_STAGE(PG8_SB(1, 0), cB + kstep, voffB); PG8_STAGE(PG8_SA(1, 0), cA + kstep, gC[0]); PG8_STAGE(PG8_SB(1, 1), cB + hstep + kstep, voffB);
        PG8_WAIT_V(6); PG8_BAR;
    } else {
        PG8_STAGE(PG8_SB(0, 0), cB, voffB); PG8_STAGE(PG8_SB(0, 1), cB + hstep, voffB); PG8_STAGE(PG8_SA(0, 0), cA, voffA); PG8_STAGE(PG8_SA(0, 1), cA + hstep, voffA);
        if (wr == 1) PG8_BAR;
        PG8_WAIT_V(2); PG8_BAR;
        PG8_STAGE(PG8_SB(1, 0), cB + kstep, voffB); PG8_STAGE(PG8_SA(1, 0), cA + kstep, voffA); PG8_STAGE(PG8_SB(1, 1), cB + hstep + kstep, voffB);
        PG8_WAIT_V(6); PG8_BAR;
    }
    for (;;) {
        const bool has_next = S.next(ui + 1, nxt);
        const char* nA = (has_next && !GATHER) ? (const char*)g.A + (size_t)nxt.pm * tstep : cA; const char* nB = has_next ? S.b_tile(g, nxt) : cB;
        if constexpr (GATHER) {
            if (has_next) {
#pragma unroll
                for (int h = 0; h < 2; ++h)
#pragma unroll
                    for (int i = 0; i < 2; ++i) gN[h][i] = S.a_rowoff(nxt, h * HALF + RA[i]) + (unsigned)CA[i] * 2u;
            }
        }
        for (int t = 0; t < nt; t += 2) {
            const bool last = (t == nt - 2);
            const char* a1 = cA + (size_t)(t + 1) * kstep;
            const char* a2 = last ? nA : cA + (size_t)(t + 2) * kstep; const char* b2 = last ? nB : cB + (size_t)(t + 2) * kstep;
            const char* a3 = a2 + kstep; const char* b3 = b2 + kstep;
            if constexpr (GATHER) {
                unsigned g2[2][2];
#pragma unroll
                for (int h = 0; h < 2; ++h)
#pragma unroll
                    for (int i = 0; i < 2; ++i) g2[h][i] = last ? gN[h][i] : gC[h][i];
                PG8_LDB(B0, 0, 0); PG8_LDB(B1, 0, 1); PG8_SCHED; PG8_LDA(At, 0, 0); PG8_STAGE(PG8_SA(1, 1), a1, gC[1]);
                PG8_WAIT_V(8); PG8_WAIT_L(0); PG8_BAR; PG8_MMA(0, 0, At, B0); PG8_MMA(0, 1, At, B1); PG8_BAR; PG8_SCHED;
                PG8_LDA(At, 0, 1); PG8_STAGE(PG8_SB(0, 0), b2, voffB); PG8_STAGE(PG8_SB(0, 1), b2 + hstep, voffB); PG8_STAGE(PG8_SA(0, 0), a2, g2[0]);
                PG8_WAIT_V(8); PG8_WAIT_L(0); PG8_BAR; PG8_MMA(1, 0, At, B0); PG8_MMA(1, 1, At, B1); PG8_BAR; PG8_SCHED;
                PG8_LDB(B0, 1, 0); PG8_LDB(B1, 1, 1); PG8_SCHED; PG8_LDA(At, 1, 0); PG8_STAGE(PG8_SA(0, 1), a2, g2[1]);
                PG8_WAIT_V(8); PG8_WAIT_L(0); PG8_BAR; PG8_MMA(0, 0, At, B0); PG8_MMA(0, 1, At, B1); PG8_BAR; PG8_SCHED;
                PG8_LDA(At, 1, 1); PG8_STAGE(PG8_SB(1, 0), b3, voffB); PG8_STAGE(PG8_SB(1, 1), b3 + hstep, voffB); PG8_STAGE(PG8_SA(1, 0), a3, g2[0]);
                PG8_WAIT_V(8); PG8_WAIT_L(0); PG8_BAR; PG8_MMA(1, 0, At, B0); PG8_MMA(1, 1, At, B1); PG8_BAR; PG8_SCHED;
            } else {
                PG8_LDB(B0, 0, 0); PG8_LDB(B1, 0, 1); PG8_SCHED; PG8_LDA(At, 0, 0); PG8_STAGE(PG8_SA(1, 1), a1 + hstep, voffA);
                PG8_WAIT_V(8); PG8_WAIT_L(0); PG8_BAR; PG8_MMA(0, 0, At, B0); PG8_MMA(0, 1, At, B1); PG8_BAR; PG8_SCHED;
                PG8_LDA(At, 0, 1); PG8_STAGE(PG8_SB(0, 0), b2, voffB); PG8_STAGE(PG8_SB(0, 1), b2 + hstep, voffB); PG8_STAGE(PG8_SA(0, 0), a2, voffA);
                PG8_WAIT_V(8); PG8_WAIT_L(0); PG8_BAR; PG8_MMA(1, 0, At, B0); PG8_MMA(1, 1, At, B1); PG8_BAR; PG8_SCHED;
                PG8_LDB(B0, 1, 0); PG8_LDB(B1, 1, 1); PG8_SCHED; PG8_LDA(At, 1, 0); PG8_STAGE(PG8_SA(0, 1), a2 + hstep, voffA);
                PG8_WAIT_V(8); PG8_WAIT_L(0); PG8_BAR; PG8_MMA(0, 0, At, B0); PG8_MMA(0, 1, At, B1); PG8_BAR; PG8_SCHED;
                PG8_LDA(At, 1, 1); PG8_STAGE(PG8_SB(1, 0), b3, voffB); PG8_STAGE(PG8_SB(1, 1), b3 + hstep, voffB); PG8_STAGE(PG8_SA(1, 0), a3, voffA);
                PG8_WAIT_V(8); PG8_WAIT_L(0); PG8_BAR; PG8_MMA(1, 0, At, B0); PG8_MMA(1, 1, At, B1); PG8_BAR; PG8_SCHED;
            }
        }
        if (wr == 0) PG8_BAR;
        E(acc, cur, wr, wc, fr, fq);
        if constexpr (epi_signal<Epi>::value) {
            if (ui == 0 && has_next) pend = cur.pm;
            else {
                PG8_WAIT_V(0); PG8_BAR;
                if (wid == 0) {
                    const unsigned pay = (unsigned)(cur.pm + 1) | ((unsigned)(pend + 1) << 12) | ((E.x + 1u) << 24);
                    if (!arrived && E.nloc != 0u) {
                        unsigned last = 0u;
                        if (lane == 0) {
                            __hip_atomic_store(E.agg + 256 + S.c, pay, __ATOMIC_RELAXED, __HIP_MEMORY_SCOPE_AGENT); asm volatile("s_waitcnt vmcnt(0)" ::: "memory");
                            const unsigned old = __hip_atomic_fetch_add(E.agg + E.x * 16, 1u, __ATOMIC_RELAXED, __HIP_MEMORY_SCOPE_AGENT);
                            last = (old + 1u == E.nloc) ? 1u : 0u;
                        }
                        last = (unsigned)__builtin_amdgcn_readfirstlane((int)last);
                        if (last) {
                            __builtin_amdgcn_fence(__ATOMIC_RELEASE, "agent"); asm volatile("s_waitcnt vmcnt(0)" ::: "memory");
                            for (int i = lane; i < S.G; i += 64) {
                                const unsigned p = __hip_atomic_load(E.agg + 256 + i, __ATOMIC_RELAXED, __HIP_MEMORY_SCOPE_AGENT);
                                if ((p >> 24) == E.x + 1u) { (void)__hip_atomic_fetch_add(E.rdy + (p & 0xfffu) - 1u, 1u, __ATOMIC_RELAXED, __HIP_MEMORY_SCOPE_AGENT);
                                    if ((p >> 12) & 0xfffu) (void)__hip_atomic_fetch_add(E.rdy + ((p >> 12) & 0xfffu) - 1u, 1u, __ATOMIC_RELAXED, __HIP_MEMORY_SCOPE_AGENT); }
                            }
                        }
                    } else if (lane == 0) {
                        __builtin_amdgcn_fence(__ATOMIC_RELEASE, "agent"); asm volatile("s_waitcnt vmcnt(0)" ::: "memory"); (void)__hip_atomic_fetch_add(E.rdy + cur.pm, 1u, __ATOMIC_RELAXED, __HIP_MEMORY_SCOPE_AGENT);
                        if (pend >= 0) (void)__hip_atomic_fetch_add(E.rdy + pend, 1u, __ATOMIC_RELAXED, __HIP_MEMORY_SCOPE_AGENT);
                    }
                }
                arrived = true; pend = -1;
            }
        }
        if (!has_next) break;
#pragma unroll
        for (int a = 0; a < 2; ++a)
#pragma unroll
            for (int b = 0; b < 2; ++b)
#pragma unroll
                for (int m = 0; m < 4; ++m)
#pragma unroll
                    for (int n = 0; n < 2; ++n) acc[a][b][m][n] = (f32x4){0.f, 0.f, 0.f, 0.f};
        cur = nxt; cA = nA; cB = nB; ++ui;
        if constexpr (GATHER) {
#pragma unroll
            for (int h = 0; h < 2; ++h)
#pragma unroll
                for (int i = 0; i < 2; ++i) gC[h][i] = gN[h][i];
        }
        if (wr == 1) PG8_BAR;
    }
    PG8_WAIT_V(0);
    PG8_BAR;
#undef PG8_SA
#undef PG8_SB
#undef PG8_STAGE
#undef PG8_LDA
#undef PG8_LDB
#undef PG8_MMA
#undef PG8_WAIT_V
#undef PG8_WAIT_L
#undef PG8_BAR
#undef PG8_SCHED
}
}

constexpr size_t MiB = 1u << 20;
constexpr size_t WS_CTL = 0, CTL_ZERO_BYTES = 1 * MiB;
constexpr size_t WS_COS = 1 * MiB, WS_SIN = 5 * MiB;
constexpr size_t WS_WAIN = 9 * MiB;
constexpr size_t WS_WAOUT = 21 * MiB;
constexpr size_t WS_WBIN = 25 * MiB;
constexpr size_t WS_WBOUT = 37 * MiB;
constexpr size_t WS_WCIN = 41 * MiB;
constexpr size_t WS_WCOUT = 53 * MiB;
constexpr size_t WS_WPROJ = 59 * MiB;
constexpr size_t WS_WGATE = 61 * MiB;
constexpr size_t WS_WGU = 69 * MiB;
constexpr size_t WS_WDN = 101 * MiB;
constexpr size_t WS_XP = 117 * MiB, WS_XQ = 149 * MiB;
constexpr size_t WS_PB = 181 * MiB;
constexpr size_t WS_ROUTE = 189 * MiB;
constexpr size_t WS_S1 = 192 * MiB;
constexpr size_t WS_R = 224 * MiB;
constexpr size_t WS_END = 512 * MiB;
constexpr size_t R_BG = 0, R_Z = 32 * MiB, R_YC = 64 * MiB, R_AWQ = 112 * MiB, R_AWQS = 116 * MiB;
constexpr size_t R_QP = 0, R_KP = 32 * MiB, R_KT = 64 * MiB, R_VT = 96 * MiB, R_GS = 160 * MiB, R_CR = 224 * MiB;
constexpr size_t R_U = 0, R_CVT = 96 * MiB, R_ST = 192 * MiB;
constexpr size_t R_WQ = 200 * MiB, R_WQS = 204 * MiB, R_Y8 = 208 * MiB;
constexpr size_t R_H = 0, R_YS = 36 * MiB, R_X2 = 108 * MiB, R_EMB = 140 * MiB;
constexpr size_t R_X2Q = 0, R_WGQ = 16 * MiB, R_CS = 17 * MiB, R_XS = 17 * MiB + 65536;
static_assert((size_t)NSLOT * DE * 2 <= 36 * MiB && (size_t)NSLOT * D * 2 <= 72 * MiB, "MoE slot buffers");
constexpr int CW_BAR = 4096;
constexpr int CW_AGG = 65536;
constexpr int CW_RDY = 32768;
constexpr int CW_CNT = 16384;

constexpr int RING_OFF = 0, RING_BYTES = 131072;
constexpr int LDSCTL_OFF = RING_BYTES, MISC_OFF = LDSCTL_OFF + 320, TAB_OFF = LDSCTL_OFF + 512;
constexpr int XPOSE_OFF = LDSCTL_OFF + 1024;
constexpr int LDS_BYTES = 163840;
constexpr int NWAVES = 8;

#define XB_TMO      128
#define XB_XCNT(j)  (256  + 64 * (j))
#define XB_XSUB(j)  (1280 + 64 * (j))
#define XB_XGEN(j)  (2304 + 64 * (j))
#define XB_TOP      3328
#define XB_TOPGEN   3392
#define XCD_BAR_WORDS 3456
#define XB_SPIN_CAP (1u << 22)
DI unsigned xb_ld(unsigned* p)              { return __hip_atomic_load(p, __ATOMIC_RELAXED, __HIP_MEMORY_SCOPE_AGENT); }
DI unsigned xb_add(unsigned* p, unsigned v) { return __hip_atomic_fetch_add(p, v, __ATOMIC_RELAXED, __HIP_MEMORY_SCOPE_AGENT); }
DI unsigned xb_xcc_id() { return (unsigned)__builtin_amdgcn_s_getreg((3 << 11) | 20) & 0xFu; }
#define XB_SPIN(cond, bar) do { unsigned _sp = 0; while (cond) { __builtin_amdgcn_s_sleep(1); \
    if ((++_sp & 255u) == 0u) { if (xb_ld(&(bar)[XB_TMO])) break; if (_sp > XB_SPIN_CAP) { atomicAdd(&(bar)[XB_TMO], 1u); break; } } } } while (0)
struct XcdBarrier { unsigned* bar; unsigned x; volatile LAS unsigned* st; };
DI XcdBarrier xcd_barrier_post(unsigned* bar, volatile LAS unsigned* st, bool t0) {
    XcdBarrier b; b.bar = bar; b.x = xb_xcc_id(); b.st = st;
    if (t0) (void)xb_add(&bar[XB_XCNT(b.x)], 1u);
    return b;
}
DI void xcd_barrier_complete(unsigned* bar, unsigned x, unsigned& nloc, unsigned& nx) {
    const unsigned G = gridDim.x * gridDim.y * gridDim.z;
    unsigned sum, cnt, mine, sp = 0u;
    for (;;) {
        sum = 0u; cnt = 0u; mine = 0u;
#pragma unroll
        for (unsigned j = 0; j < 16; ++j) { const unsigned c = xb_ld(&bar[XB_XCNT(j)]); sum += c; cnt += (c > 0u) ? 1u : 0u; mine = (j == x) ? c : mine; }
        if (sum == G) break;
        __builtin_amdgcn_s_sleep(1);
        if ((++sp & 255u) == 0u) { if (xb_ld(&bar[XB_TMO])) break; if (sp > XB_SPIN_CAP) { atomicAdd(&bar[XB_TMO], 1u); break; } }
    }
    nloc = mine > 0u ? mine : 1u; nx = cnt > 0u ? cnt : 1u;
}
DI void xcd_barrier(const XcdBarrier& b, bool t0) {
    asm volatile("s_waitcnt vmcnt(0)" ::: "memory");
    __syncthreads();
    if (t0) {
        unsigned* bar = b.bar;
        __builtin_amdgcn_s_waitcnt(0);
        unsigned nloc = b.st[0], nx = b.st[1];
        if (nloc == 0u) { xcd_barrier_complete(bar, b.x, nloc, nx); b.st[0] = nloc; b.st[1] = nx; }
        const unsigned old = xb_add(&bar[XB_XSUB(b.x)], 1u);
        asm volatile("buffer_inv sc1" ::: "memory");
        const unsigned gen = old / nloc;
        if (old + 1u == (gen + 1u) * nloc) {
            __builtin_amdgcn_fence(__ATOMIC_RELEASE, "agent");
            asm volatile("s_waitcnt vmcnt(0)" ::: "memory");
            const unsigned og = xb_add(&bar[XB_TOP], 1u);
            const unsigned tg = og / nx;
            if (og + 1u == (tg + 1u) * nx) xb_add(&bar[XB_TOPGEN], 1u);
            else XB_SPIN(xb_ld(&bar[XB_TOPGEN]) == tg, bar);
            xb_add(&bar[XB_XGEN(b.x)], 1u);
            asm volatile("s_waitcnt vmcnt(0)" ::: "memory");
        } else {
            XB_SPIN(xb_ld(&bar[XB_XGEN(b.x)]) == gen, bar);
            asm volatile("s_waitcnt vmcnt(0)" ::: "memory");
        }
    }
    __syncthreads();
}

struct Frame {
    LAS unsigned char* lds;
    unsigned* ctl;
    unsigned char* ws;
    int tid, lane, wave, vcu, G, bx;
};
struct Args { const void* in[23]; float* out; unsigned char* ws; int ph_lo, ph_hi; };
enum { I_X = 0, I_P, I_AWIN, I_ACONV, I_AWOUT, I_BWIN, I_BWOUT, I_CWIN, I_CLNG, I_CLNB, I_CWS, I_CBS, I_CWOUT, I_RW, I_RB, I_MG, I_MU, I_MD, I_LNG, I_LNB, I_PPROJ, I_PGATE, I_PBG };
typedef const __attribute__((address_space(4))) Args CArgs;
DI CArgs* kargs() { unsigned long long p = (unsigned long long)__builtin_amdgcn_kernarg_segment_ptr(); asm volatile("" : "+s"(p)); return (CArgs*)p; }
DI int cur_tid(int wv) { int w = wv; unsigned m = ~0u; asm volatile("" : "+s"(w), "+s"(m)); return w * 64 + (int)__builtin_amdgcn_mbcnt_hi(m, __builtin_amdgcn_mbcnt_lo(m, 0u)); }
DI Frame mkframe(CArgs* ap, int wv) {
    extern __shared__ __attribute__((aligned(16))) unsigned char lds[];
    int tid = cur_tid(wv), bx = blockIdx.x, G = gridDim.x;
    asm volatile("" : "+v"(tid)); asm volatile("" : "+s"(bx)); asm volatile("" : "+s"(G));
    Frame F; F.lds = (LAS unsigned char*)lds; F.tid = tid; F.lane = F.tid & 63; F.wave = __builtin_amdgcn_readfirstlane(F.tid >> 6);
    F.G = G; F.bx = bx; F.vcu = (F.G % 8 == 0) ? (bx % 8) * (F.G / 8) + bx / 8 : bx;
    F.ws = ap->ws; F.ctl = (unsigned*)(ap->ws + WS_CTL); return F;
}

DI void cvt_job(Frame& F, const float* W, int ld, int K, int ncols, bf16_t* WT, int rowbase, int mode, int nmat, size_t sstride, size_t dstride, int& base) {
    LAS unsigned char* scr = F.lds + RING_OFF + F.wave * 16384;
    const int gw = F.vcu * NWAVES + F.wave, NGW = F.G * NWAVES, nblk = ncols / 64, per = (K / 64) * nblk, items = per * nmat, lane = F.lane;
    const int first = (gw + NGW - (base % NGW)) % NGW; base += items;
    for (int it = first; it < items; it += NGW) {
        const int mat = it / per, r = it - mat * per, kb = r / nblk, nb = r - kb * nblk, k0 = 64 * kb, n0 = 64 * nb;
        const float* p = W + (size_t)mat * sstride + (size_t)(k0 + (lane >> 4)) * ld + n0 + 4 * (lane & 15);
        f32x4 v[16];
#pragma unroll
        for (int i = 0; i < 16; ++i) v[i] = __builtin_nontemporal_load((const f32x4*)(p + (size_t)(4 * i) * ld));
#pragma unroll
        for (int i = 0; i < 16; ++i) { u32x2 w; w.x = pk2(v[i][0], v[i][1]); w.y = pk2(v[i][2], v[i][3]); *(LAS u32x2*)(scr + ((lane >> 4) + 4 * i) * 136 + (lane & 15) * 8) = w; }
        LDS_WAIT(); asm volatile("" ::: "memory");
        const int r0 = rowbase + (mode == 0 ? n0 : (n0 >> 7) * 256 + (mode - 1) * 128 + (n0 & 127)), c = lane & 7;
        bf16_t* dst = WT + (size_t)mat * dstride + (size_t)r0 * K + k0 + 8 * c;
#pragma unroll
        for (int j = 0; j < 8; ++j) { const int n = (lane >> 3) + 8 * j; const LAS unsigned short* s = (const LAS unsigned short*)(scr + (8 * c) * 136 + n * 2);
            u32x4 o; o.x = (unsigned)s[0] | ((unsigned)s[68] << 16); o.y = (unsigned)s[2 * 68] | ((unsigned)s[3 * 68] << 16); o.z = (unsigned)s[4 * 68] | ((unsigned)s[5 * 68] << 16); o.w = (unsigned)s[6 * 68] | ((unsigned)s[7 * 68] << 16);
            *(u32x4*)(dst + (size_t)n * K) = o; }
        LDS_WAIT(); asm volatile("" ::: "memory");
    }
}
DI void cvt_flat(Frame& F, const float* src, bf16_t* dst, size_t n) {
    const size_t nth = (size_t)F.G * 512, t0 = (size_t)F.vcu * 512 + F.tid;
    for (size_t i = t0; i < n / 8; i += nth) { const f32x4 a = __builtin_nontemporal_load((const f32x4*)(src + i * 8)), b = __builtin_nontemporal_load((const f32x4*)(src + i * 8 + 4)); *(u32x4*)(dst + i * 8) = pk8(a, b); }
}

DI void p0_prologue(Frame& F, CArgs* ap) {
    unsigned char* ws = F.ws;
    int base = 0;
    { const float* w = (const float*)ap->in[I_AWIN]; bf16_t* d = (bf16_t*)(ws + WS_WAIN);
      cvt_job(F, w, 3072, D, 1024, d, 0, 0, 2, (size_t)D * 3072, (size_t)3072 * D, base);
      cvt_job(F, w + 1024, 3072, D, 1024, d, 1024, 1, 2, (size_t)D * 3072, (size_t)3072 * D, base);
      cvt_job(F, w + 2048, 3072, D, 1024, d, 1024, 2, 2, (size_t)D * 3072, (size_t)3072 * D, base); }
    cvt_job(F, (const float*)ap->in[I_AWOUT], D, D, D, (bf16_t*)(ws + WS_WAOUT), 0, 0, 2, (size_t)D * D, (size_t)D * D, base);
    cvt_job(F, (const float*)ap->in[I_BWIN], 6144, D, 6144, (bf16_t*)(ws + WS_WBIN), 0, 0, 1, 0, 0, base);
    cvt_job(F, (const float*)ap->in[I_BWOUT], D, VD, D, (bf16_t*)(ws + WS_WBOUT), 0, 0, 1, 0, 0, base);
    cvt_job(F, (const float*)ap->in[I_CWIN], 6144, D, 6144, (bf16_t*)(ws + WS_WCIN), 0, 0, 1, 0, 0, base);
    cvt_job(F, (const float*)ap->in[I_CWOUT], D, SH, D, (bf16_t*)(ws + WS_WCOUT), 0, 0, 1, 0, 0, base);
    cvt_job(F, (const float*)ap->in[I_PPROJ], D, PLE, D, (bf16_t*)(ws + WS_WPROJ), 0, 0, DEPTH, (size_t)PLE * D, (size_t)D * PLE, base);
    cvt_job(F, (const float*)ap->in[I_PGATE], D, D, D, (bf16_t*)(ws + WS_WGATE), 0, 0, DEPTH, (size_t)D * D, (size_t)D * D, base);
    cvt_flat(F, (const float*)ap->in[I_X], (bf16_t*)(ws + WS_XP), (size_t)M * D);
    float* COS = (float*)(ws + WS_COS); float* SIN = (float*)(ws + WS_SIN);
    for (int i = F.vcu * 512 + F.tid; i < SEQ * 128; i += F.G * 512) {
        const int pos = i >> 7, j = i & 127;
        const float lin = (float)j * (1.0f / 127.0f);
        const float invf = 1.0f / __builtin_powf(10000.0f, lin);
        const float ang = (float)pos * invf;
        const double x = (double)ang, k = __builtin_rint(x * 0.15915494309189535);
        double r = x - k * 6.283185307179586; double sgn = 1.0;
        if (r > 1.5707963267948966) { r = 3.141592653589793 - r; sgn = -1.0; } else if (r < -1.5707963267948966) { r = -3.141592653589793 - r; sgn = -1.0; }
        const double r2 = r * r;
        const double sv = r * (1.0 + r2 * (-1.0 / 6 + r2 * (1.0 / 120 + r2 * (-1.0 / 5040 + r2 * (1.0 / 362880 + r2 * (-1.0 / 39916800 + r2 * (1.0 / 6227020800.0)))))));
        const double cv = 1.0 + r2 * (-0.5 + r2 * (1.0 / 24 + r2 * (-1.0 / 720 + r2 * (1.0 / 40320 + r2 * (-1.0 / 3628800 + r2 * (1.0 / 479001600 + r2 * (-1.0 / 87178291200.0)))))));
        COS[i] = (float)(sgn * cv); SIN[i] = (float)sv;
    }
}

template <int NP> DI void quant_row_e4m3(const bf16_t* wrow, unsigned char* qrow, float* qs, int lane) {
    u32x4 r[NP][2]; float am = 0.f;
#pragma unroll
    for (int p = 0; p < NP; ++p) { r[p][0] = *(const u32x4*)(wrow + p * 1024 + 16 * lane); r[p][1] = *(const u32x4*)(wrow + p * 1024 + 16 * lane + 8);
#pragma unroll
        for (int h = 0; h < 2; ++h) { f32x4 a, b; unpk8(r[p][h], a, b);
#pragma unroll
            for (int j = 0; j < 4; ++j) am = __builtin_fmaxf(am, __builtin_fmaxf(__builtin_fabsf(a[j]), __builtin_fabsf(b[j]))); } }
    am = wave_max_pos(am);
    const int e = am > 0.f ? __builtin_amdgcn_frexp_expf(am) : 0; const float sc = __builtin_amdgcn_ldexpf(1.0f, 7 - e);
#pragma unroll
    for (int p = 0; p < NP; ++p) { f32x4 a0, a1, b0, b1; unpk8(r[p][0], a0, a1); unpk8(r[p][1], b0, b1);
        u32x4 o; o.x = pk4_fp8(a0[0] * sc, a0[1] * sc, a0[2] * sc, a0[3] * sc); o.y = pk4_fp8(a1[0] * sc, a1[1] * sc, a1[2] * sc, a1[3] * sc);
        o.z = pk4_fp8(b0[0] * sc, b0[1] * sc, b0[2] * sc, b0[3] * sc); o.w = pk4_fp8(b1[0] * sc, b1[1] * sc, b1[2] * sc, b1[3] * sc);
        *(u32x4*)(qrow + p * 1024 + 16 * lane) = o; }
    if (lane == 0) *qs = __builtin_amdgcn_ldexpf(1.0f, e - 7);
}

DI void phase_conv(Frame& F, const bf16_t* BG, const bf16_t* Z, const float* cw, unsigned char* YC8, const bf16_t* WO, unsigned char* WQ, float* WQS) {
    { const int n = F.vcu * NWAVES + F.wave; if (n < D) quant_row_e4m3<1>(WO + (size_t)n * D, WQ + (size_t)n * D, WQS + n, F.lane); }
    const int sub = F.tid >> 7, cl = F.tid & 127, c0 = cl * 8;
    float w0[8], w1[8], w2[8];
#pragma unroll
    for (int j = 0; j < 8; ++j) { w0[j] = cw[c0 + j]; w1[j] = cw[D + c0 + j]; w2[j] = cw[2 * D + c0 + j]; }
    for (int run = F.vcu * 4 + sub; run < M / 16; run += F.G * 4) {
        const int t0 = run * 16; const bool first = (t0 & (SEQ - 1)) == 0;
        f32x4 za0, za1, zb0, zb1;
        if (first) { za0 = za1 = zb0 = zb1 = (f32x4){0.f, 0.f, 0.f, 0.f}; }
        else { unpk8(*(const u32x4*)(Z + (size_t)(t0 - 2) * D + c0), za0, za1); unpk8(*(const u32x4*)(Z + (size_t)(t0 - 1) * D + c0), zb0, zb1); }
#pragma unroll 4
        for (int t = t0; t < t0 + 16; ++t) {
            f32x4 z0, z1, b0, b1; unpk8(*(const u32x4*)(Z + (size_t)t * D + c0), z0, z1); unpk8(*(const u32x4*)(BG + (size_t)t * D + c0), b0, b1);
            f32x4 y0, y1;
#pragma unroll
            for (int j = 0; j < 4; ++j) { y0[j] = b0[j] * (w0[j] * za0[j] + w1[j] * zb0[j] + w2[j] * z0[j]); y1[j] = b1[j] * (w0[4 + j] * za1[j] + w1[4 + j] * zb1[j] + w2[4 + j] * z1[j]); }
            { u32x2 o8; o8.x = pk4_fp8c(y0[0] * YC8S, y0[1] * YC8S, y0[2] * YC8S, y0[3] * YC8S); o8.y = pk4_fp8c(y1[0] * YC8S, y1[1] * YC8S, y1[2] * YC8S, y1[3] * YC8S); *(u32x2*)(YC8 + (size_t)t * D + c0) = o8; }
            za0 = zb0; za1 = zb1; zb0 = z0; zb1 = z1;
        }
    }
}

DI void ln16(float (&v)[16], const float (&g)[16], const float (&b)[16], int lane) {
    float s = 0.f;
#pragma unroll
    for (int j = 0; j < 16; ++j) s += v[j];
    const float mean = wave_sum(s, lane) * (1.0f / D); float q = 0.f;
#pragma unroll
    for (int j = 0; j < 16; ++j) { v[j] -= mean; q += v[j] * v[j]; }
    const float rstd = __builtin_amdgcn_rsqf(wave_sum(q, lane) * (1.0f / D) + LN_EPS);
#pragma unroll
    for (int j = 0; j < 16; ++j) v[j] = v[j] * rstd * g[j] + b[j];
}
DI void load16(const bf16_t* row, int lane, float (&v)[16]) {
    f32x4 a0, a1, b0, b1; unpk8(*(const u32x4*)(row + 8 * lane), a0, a1); unpk8(*(const u32x4*)(row + 512 + 8 * lane), b0, b1);
#pragma unroll
    for (int j = 0; j < 4; ++j) { v[j] = a0[j]; v[4 + j] = a1[j]; v[8 + j] = b0[j]; v[12 + j] = b1[j]; }
}
DI void load16f(const float* p, int lane, float (&v)[16]) {
#pragma unroll
    for (int j = 0; j < 8; ++j) { v[j] = p[8 * lane + j]; v[8 + j] = p[512 + 8 * lane + j]; }
}
DI void store16(bf16_t* row, int lane, const float (&v)[16]) {
    *(u32x4*)(row + 8 * lane) = pk8((f32x4){v[0], v[1], v[2], v[3]}, (f32x4){v[4], v[5], v[6], v[7]});
    *(u32x4*)(row + 512 + 8 * lane) = pk8((f32x4){v[8], v[9], v[10], v[11]}, (f32x4){v[12], v[13], v[14], v[15]});
}

DI void phase_ln1_route(Frame& F, CArgs* ap, int L, const bf16_t* S1, bf16_t* X1, const bool dry, unsigned char* X1Q) {
    unsigned char* ws = F.ws;
    const int gw = F.vcu * NWAVES + F.wave, NGW = F.G * NWAVES;
    const bool inter = (NGW == 2048);
    if (!inter) {
        { int base = 0; const size_t l0 = (size_t)L * NE;
          cvt_job(F, (const float*)ap->in[I_MG] + l0 * D * DE, DE, D, DE, (bf16_t*)(ws + WS_WGU), 0, 1, NE, (size_t)D * DE, (size_t)1024 * D, base);
          cvt_job(F, (const float*)ap->in[I_MU] + l0 * D * DE, DE, D, DE, (bf16_t*)(ws + WS_WGU), 0, 2, NE, (size_t)D * DE, (size_t)1024 * D, base);
          cvt_job(F, (const float*)ap->in[I_MD] + l0 * DE * D, D, DE, D, (bf16_t*)(ws + WS_WDN), 0, 0, NE, (size_t)DE * D, (size_t)D * DE, base); }
        cvt_flat(F, (const float*)ap->in[I_P] + (size_t)L * M * PLE, (bf16_t*)(ws + WS_PB), (size_t)M * PLE);
        __syncthreads();
    }
    LAS float* RW = (LAS float*)(F.lds + RING_OFF);
    LAS unsigned char* scr = F.wave < 7 ? F.lds + RING_OFF + 65536 + F.wave * 8704 : F.lds + XPOSE_OFF;
    const float* rw = (const float*)ap->in[I_RW];
    for (int i = F.tid; i < D * NE; i += 512) RW[(i & 15) * D + (i >> 4)] = rw[i];
    float g[16], b[16]; load16f((const float*)ap->in[I_LNG] + (size_t)(L * 2 + 0) * D, F.lane, g); load16f((const float*)ap->in[I_LNB] + (size_t)(L * 2 + 0) * D, F.lane, b);
    const float* rb = (const float*)ap->in[I_RB];
    const float rbl = rb[((F.lane >> 5) & 1) * 8 + ((F.lane >> 4) & 1) * 4 + ((F.lane >> 3) & 1) * 2 + ((F.lane >> 2) & 1)];
    int* TOK_E = (int*)(ws + WS_ROUTE); int* TOK_POS = TOK_E + 2 * M; float* TOK_W = (float*)(TOK_POS + 2 * M); int* LIST = (int*)(TOK_W + 2 * M);
    unsigned* cnt = F.ctl + CW_CNT + (size_t)L * NE * 64;
    __syncthreads();
    const float* psrc = (const float*)ap->in[I_P] + (size_t)L * M * PLE; bf16_t* pdst = (bf16_t*)(ws + WS_PB);
    const size_t pth = (size_t)F.G * 512, pt0 = (size_t)F.vcu * 512 + F.tid;
    u32x4 nx0 = *(const u32x4*)(S1 + (size_t)gw * D + 8 * F.lane), nx1 = *(const u32x4*)(S1 + (size_t)gw * D + 512 + 8 * F.lane);
    int kk = 0;
    for (int t = gw; t < M; t += NGW, ++kk) {
        const u32x4 c0 = nx0, c1 = nx1;
        { const int tn = t + NGW < M ? t + NGW : t; nx0 = *(const u32x4*)(S1 + (size_t)tn * D + 8 * F.lane); nx1 = *(const u32x4*)(S1 + (size_t)tn * D + 512 + 8 * F.lane); }
        const bool dot = inter && (kk == 0 || kk == 3 || kk == 6), dop = inter && (kk == 1 || kk == 2 || kk == 4 || kk == 5);
        f32x4 tv[16]; bf16_t* tdst = nullptr; int tK = 0; f32x4 pa = {0.f, 0.f, 0.f, 0.f}, pb = pa; size_t pi = 0; f32x4 tsmp = pa; int tkb = 0, tcs = 0;
        if (dot) {
            const int job = kk / 3, lane = F.lane; const size_t l0 = (size_t)L * NE;
            const float* W = (const float*)ap->in[job == 0 ? I_MG : job == 1 ? I_MU : I_MD] + l0 * D * DE;
            const int ld = job == 2 ? D : DE, K = job == 2 ? DE : D, nblk = job == 2 ? 16 : 8, mode = job == 2 ? 0 : job + 1;
            const int mat = gw >> 7, r = gw & 127, kb = r / nblk, nb = r - kb * nblk, k0 = 64 * kb, n0 = 64 * nb;
            const float* p = W + (size_t)mat * ((size_t)D * DE) + (size_t)(k0 + (lane >> 4)) * ld + n0 + 4 * (lane & 15);
#pragma unroll
            for (int i = 0; i < 16; ++i) tv[i] = __builtin_nontemporal_load((const f32x4*)(p + (size_t)(4 * i) * ld));
            { tsmp = *(const f32x4*)(W + (size_t)mat * ((size_t)D * DE) + (size_t)(lane >> 4) * ld + n0 + 4 * (lane & 15)); tkb = kb; tcs = mat * 1024 + (mode == 0 ? n0 : (n0 >> 7) * 256 + (mode - 1) * 128 + (n0 & 127)); }
            const int r0 = mode == 0 ? n0 : (n0 >> 7) * 256 + (mode - 1) * 128 + (n0 & 127);
            tdst = (bf16_t*)(ws + (job == 2 ? WS_WDN : WS_WGU)) + (size_t)mat * (job == 2 ? (size_t)D * DE : (size_t)1024 * D) + (size_t)r0 * K + k0 + 8 * (lane & 7); tK = K;
            tdst = (bf16_t*)(ws + (job == 2 ? WS_WDN : WS_WGU) + (size_t)mat * (1024 * K) + (size_t)r0 * K + k0 + 8 * (lane & 7));
        } else {
#pragma unroll
            for (int i = 0; i < 16; ++i) tv[i] = (f32x4){0.f, 0.f, 0.f, 0.f};
        }
        if (dop) { pi = pt0 + (size_t)(kk - 1 - (kk > 3 ? 1 : 0)) * pth; pa = __builtin_nontemporal_load((const f32x4*)(psrc + pi * 8)); pb = __builtin_nontemporal_load((const f32x4*)(psrc + pi * 8 + 4)); }
        asm volatile("" ::: "memory");
        float v[16]; { f32x4 a0, a1, b0, b1; unpk8(c0, a0, a1); unpk8(c1, b0, b1);
#pragma unroll
            for (int j = 0; j < 4; ++j) { v[j] = a0[j]; v[4 + j] = a1[j]; v[8 + j] = b0[j]; v[12 + j] = b1[j]; } }
        ln16(v, g, b, F.lane);
        if (!dry) store16(X1 + (size_t)t * D, F.lane, v);
        float xsinv = 0.f;
        if (inter) {
            float am = 0.f;
#pragma unroll
            for (int j = 0; j < 16; ++j) am = __builtin_fmaxf(am, __builtin_fabsf(v[j]));
            am = wave_max_pos(am);
            const int e = am > 0.f ? __builtin_amdgcn_frexp_expf(am) : 0; const float qs = __builtin_amdgcn_ldexpf(1.0f, 7 - e); xsinv = __builtin_amdgcn_ldexpf(1.0f, e - 7);
            u32x2 q0, q1; q0.x = pk4_fp8(v[0] * qs, v[1] * qs, v[2] * qs, v[3] * qs); q0.y = pk4_fp8(v[4] * qs, v[5] * qs, v[6] * qs, v[7] * qs);
            q1.x = pk4_fp8(v[8] * qs, v[9] * qs, v[10] * qs, v[11] * qs); q1.y = pk4_fp8(v[12] * qs, v[13] * qs, v[14] * qs, v[15] * qs);
            if (!dry) { *(u32x2*)(X1Q + (size_t)t * D + 8 * F.lane) = q0; *(u32x2*)(X1Q + (size_t)t * D + 512 + 8 * F.lane) = q1; }
        }
        float sc[16]; int re1 = 0, re2 = 0; float w1 = 0.f, w2 = 0.f;
#pragma unroll
        for (int e = 0; e < NE; ++e) {
            const LAS float* r = RW + e * D;
            const f32x4 r0 = *(const LAS f32x4*)(r + 8 * F.lane), r1 = *(const LAS f32x4*)(r + 8 * F.lane + 4), r2 = *(const LAS f32x4*)(r + 512 + 8 * F.lane), r3 = *(const LAS f32x4*)(r + 512 + 8 * F.lane + 4);
            float p = 0.f;
#pragma unroll
            for (int j = 0; j < 4; ++j) p += v[j] * r0[j] + v[4 + j] * r1[j] + v[8 + j] * r2[j] + v[12 + j] * r3[j];
            sc[e] = p;
            if ((e & 3) == 3) asm volatile("" ::: "memory");
        }
        { const int ln = F.lane;
#pragma unroll
          for (int j = 0; j < 8; ++j) { const float keep = (ln & 32) ? sc[8 + j] : sc[j], give = (ln & 32) ? sc[j] : sc[8 + j]; sc[j] = keep + shx(give, 32, ln); }
#pragma unroll
          for (int j = 0; j < 4; ++j) { const float keep = (ln & 16) ? sc[4 + j] : sc[j], give = (ln & 16) ? sc[j] : sc[4 + j]; sc[j] = keep + shx(give, 16, ln); }
#pragma unroll
          for (int j = 0; j < 2; ++j) { const float keep = (ln & 8) ? sc[2 + j] : sc[j], give = (ln & 8) ? sc[j] : sc[2 + j]; sc[j] = keep + shx(give, 8, ln); }
          { const float keep = (ln & 4) ? sc[1] : sc[0], give = (ln & 4) ? sc[0] : sc[1]; sc[0] = keep + shx(give, 4, ln); }
          DPP_ADD(sc[0], 0xB1, 0xf); DPP_ADD(sc[0], 0x4E, 0xf);
          const float mine = __builtin_amdgcn_rcpf(1.0f + __builtin_amdgcn_exp2f(sc[0] * -1.4426950408889634f));
          const int grp = ln >> 4, mem = (ln >> 2) & 3;
          const float selv = mine + rbl;
          const float v1 = shx(selv, 4, ln), v2 = shx(selv, 8, ln), v3 = shx(selv, 12, ln);
          const float pa = fmaxf(selv, v1), pb = fminf(selv, v1), pc = fmaxf(v2, v3), pd = fminf(v2, v3);
          const float gs = fmaxf(pa, pc) + fmaxf(fminf(pa, pc), fmaxf(pb, pd));
          const float g1 = shx(gs, 16, ln), g2 = shx(gs, 32, ln), g3 = shx(gs, 48, ln);
          const bool inbest = ((gs > g1) || (gs == g1 && grp < (grp ^ 1))) && ((gs > g2) || (gs == g2 && grp < (grp ^ 2))) && ((gs > g3) || (gs == g3 && grp < (grp ^ 3)));
          const int rank = (((v1 > selv) || (v1 == selv && (mem ^ 1) < mem)) ? 1 : 0) + (((v2 > selv) || (v2 == selv && (mem ^ 2) < mem)) ? 1 : 0) + (((v3 > selv) || (v3 == selv && (mem ^ 3) < mem)) ? 1 : 0);
          const unsigned long long mk1 = __builtin_amdgcn_ballot_w64(inbest && rank == 0), mk2 = __builtin_amdgcn_ballot_w64(inbest && rank == 1);
          const int l1 = __builtin_ctzll(mk1 | (1ull << 63)), l2 = __builtin_ctzll(mk2 | (1ull << 63));
          re1 = ((l1 >> 5) & 1) * 8 + ((l1 >> 4) & 1) * 4 + ((l1 >> 3) & 1) * 2 + ((l1 >> 2) & 1); re2 = ((l2 >> 5) & 1) * 8 + ((l2 >> 4) & 1) * 4 + ((l2 >> 3) & 1) * 2 + ((l2 >> 2) & 1);
          w1 = __builtin_bit_cast(float, __builtin_amdgcn_readlane(__builtin_bit_cast(int, mine), l1)); w2 = __builtin_bit_cast(float, __builtin_amdgcn_readlane(__builtin_bit_cast(int, mine), l2));
        }
        const float inv = 1.0f / (w1 + w2);
        if (F.lane == 0 && !dry) {
            const int e1 = re1, e2 = re2;
            const int p1 = (int)xb_add(cnt + e1 * 64, 1u), p2 = (int)xb_add(cnt + e2 * 64, 1u);
            LIST[(size_t)e1 * M + p1] = t; LIST[(size_t)e2 * M + p2] = t;
            if (inter) { float* SL = (float*)(LIST + 16 * M); SL[(size_t)e1 * M + p1] = xsinv; SL[(size_t)e2 * M + p2] = xsinv; }
            TOK_E[2 * t] = e1; TOK_E[2 * t + 1] = e2; TOK_POS[2 * t] = p1; TOK_POS[2 * t + 1] = p2; TOK_W[2 * t] = w1 * inv; TOK_W[2 * t + 1] = w2 * inv;
        }
        if (dot) {
            const int lane = F.lane, c = lane & 7;
#pragma unroll
            for (int i = 0; i < 16; ++i) { u32x2 w; w.x = pk2(tv[i][0], tv[i][1]); w.y = pk2(tv[i][2], tv[i][3]); *(LAS u32x2*)(scr + ((lane >> 4) + 4 * i) * 136 + (lane & 15) * 8) = w; }
            LDS_WAIT(); asm volatile("" ::: "memory");
            if (true) {
                float am = __builtin_fmaxf(__builtin_fmaxf(__builtin_fabsf(tsmp[0]), __builtin_fabsf(tsmp[1])), __builtin_fmaxf(__builtin_fabsf(tsmp[2]), __builtin_fabsf(tsmp[3])));
                am = wave_max_pos(am);
                const int e = am > 0.f ? __builtin_amdgcn_frexp_expf(am) : 0; const float qs = __builtin_amdgcn_ldexpf(1.0f, 6 - e);
                if (tkb == 0) ((float*)(kk < 6 ? ws + WS_WGU + 16 * MiB : ws + WS_WDN + 8 * MiB))[tcs + lane] = __builtin_amdgcn_ldexpf(1.0f, e - 6);
#pragma unroll
                for (int j = 0; j < 8; ++j) { const int n = (lane >> 3) + 8 * j; const LAS unsigned short* s = (const LAS unsigned short*)(scr + (8 * c) * 136 + n * 2);
                    float f[8];
#pragma unroll
                    for (int q = 0; q < 8; ++q) f[q] = __builtin_bit_cast(float, (unsigned)s[q * 68] << 16) * qs;
                    u32x2 o; o.x = pk4_fp8c(f[0], f[1], f[2], f[3]); o.y = pk4_fp8c(f[4], f[5], f[6], f[7]);
                    *(u32x2*)((unsigned char*)tdst + (size_t)n * tK) = o; }
            } else {
#pragma unroll
            for (int j = 0; j < 8; ++j) { const int n = (lane >> 3) + 8 * j; const LAS unsigned short* s = (const LAS unsigned short*)(scr + (8 * c) * 136 + n * 2);
                u32x4 o; o.x = (unsigned)s[0] | ((unsigned)s[68] << 16); o.y = (unsigned)s[2 * 68] | ((unsigned)s[3 * 68] << 16); o.z = (unsigned)s[4 * 68] | ((unsigned)s[5 * 68] << 16); o.w = (unsigned)s[6 * 68] | ((unsigned)s[7 * 68] << 16);
                *(u32x4*)(tdst + (size_t)n * tK) = o; }
            }
            LDS_WAIT(); asm volatile("" ::: "memory");
        }
        if (dop) *(u32x4*)(pdst + pi * 8) = pk8(pa, pb);
    }
    __syncthreads();
}
DI int moe_c2(const Frame& F, int n1) {
    if (F.G % 8 != 0 || n1 <= 0 || n1 >= F.G) return F.vcu;
    if (F.bx < n1) return F.bx;
    const int per = F.G / 8, x = F.vcu / per, i = F.vcu % per;
    int before = 0;
#pragma unroll
    for (int xx = 0; xx < 8; ++xx) { const int cnt = n1 > xx ? (n1 - xx + 7) / 8 : 0; before += xx < x ? cnt : (xx == x ? (i < cnt ? i : cnt) : 0); }
    return n1 + (F.vcu - before);
}
DI void moe_table(Frame& F, int L) {
    LAS int* tab = (LAS int*)(F.lds + TAB_OFF);
    if (F.tid < 64) {
        unsigned* cnt = F.ctl + CW_CNT + (size_t)L * NE * 64; const int ln = F.lane;
        const int c = ln < NE ? (int)xb_ld(cnt + ln * 64) : 0; int t = (c + 255) >> 8;
#pragma unroll
        for (int o = 1; o < 16; o <<= 1) { const int up = __builtin_amdgcn_ds_bpermute(((ln - o) & 63) << 2, t); if ((ln & 15) >= o) t += up; }
        if (ln < NE) { tab[ln + 1] = t; tab[32 + ln] = c; }
        if (ln == 0) tab[0] = 0;
    }
    __syncthreads();
}
DI void phase_ln2(Frame& F, CArgs* ap, int L, const bf16_t* X1, const bf16_t* YS, bf16_t* X2, unsigned char* X2Q, float* XS, unsigned char* WGQ, float* CS) {
    LAS int* tab = (LAS int*)(F.lds + TAB_OFF);
    { const int n = F.vcu * NWAVES + F.wave;
      if (n < D) { const bf16_t* wr = (const bf16_t*)(F.ws + WS_WGATE) + (size_t)L * D * D + (size_t)n * D + 16 * F.lane;
          f32x4 a0, a1, b0, b1; unpk8(*(const u32x4*)wr, a0, a1); unpk8(*(const u32x4*)(wr + 8), b0, b1);
          float am = 0.f;
#pragma unroll
          for (int j = 0; j < 4; ++j) am = __builtin_fmaxf(am, __builtin_fmaxf(__builtin_fmaxf(__builtin_fabsf(a0[j]), __builtin_fabsf(a1[j])), __builtin_fmaxf(__builtin_fabsf(b0[j]), __builtin_fabsf(b1[j]))));
          am = wave_max_pos(am);
          const int e = am > 0.f ? __builtin_amdgcn_frexp_expf(am) : 0; const float sc = __builtin_amdgcn_ldexpf(1.0f, 7 - e);
          u32x4 o; o.x = pk4_fp8(a0[0] * sc, a0[1] * sc, a0[2] * sc, a0[3] * sc); o.y = pk4_fp8(a1[0] * sc, a1[1] * sc, a1[2] * sc, a1[3] * sc);
          o.z = pk4_fp8(b0[0] * sc, b0[1] * sc, b0[2] * sc, b0[3] * sc); o.w = pk4_fp8(b1[0] * sc, b1[1] * sc, b1[2] * sc, b1[3] * sc);
          *(u32x4*)(WGQ + (size_t)n * D + 16 * F.lane) = o;
          if (F.lane == 0) CS[n] = __builtin_amdgcn_ldexpf(1.0f, e - 7); } }
    float g[16], b[16]; load16f((const float*)ap->in[I_LNG] + (size_t)(L * 2 + 1) * D, F.lane, g); load16f((const float*)ap->in[I_LNB] + (size_t)(L * 2 + 1) * D, F.lane, b);
    const int* TOK_E = (const int*)(F.ws + WS_ROUTE); const int* TOK_POS = TOK_E + 2 * M; const float* TOK_W = (const float*)(TOK_POS + 2 * M);
    const int gw = F.vcu * NWAVES + F.wave, NGW = F.G * NWAVES;
    struct Rec { int e1, e2, p1, p2; float w1, w2; };
    struct Rows { u32x4 x[2], a[2], b[2]; };
    auto ld_rec = [&](int t) { Rec r; r.e1 = TOK_E[2 * t]; r.e2 = TOK_E[2 * t + 1]; r.p1 = TOK_POS[2 * t]; r.p2 = TOK_POS[2 * t + 1]; r.w1 = TOK_W[2 * t]; r.w2 = TOK_W[2 * t + 1]; return r; };
    auto ld_rows = [&](int t, const Rec& r) { Rows o; const size_t s1 = (size_t)tab[r.e1] * 256 + r.p1, s2 = (size_t)tab[r.e2] * 256 + r.p2;
        const bf16_t* px = X1 + (size_t)t * D + 8 * F.lane; const bf16_t* pa = YS + s1 * D + 8 * F.lane; const bf16_t* pb = YS + s2 * D + 8 * F.lane;
        o.x[0] = *(const u32x4*)px; o.x[1] = *(const u32x4*)(px + 512); o.a[0] = *(const u32x4*)pa; o.a[1] = *(const u32x4*)(pa + 512); o.b[0] = *(const u32x4*)pb; o.b[1] = *(const u32x4*)(pb + 512); return o; };
    if (gw < M) {
        Rec rc = ld_rec(gw); Rec rn = ld_rec(gw + NGW < M ? gw + NGW : gw);
        Rows cur = ld_rows(gw, rc);
        for (int t = gw; t < M; t += NGW) {
            const int t1 = t + NGW < M ? t + NGW : t, t2 = t + 2 * NGW < M ? t + 2 * NGW : t1;
            const Rows nxt = ld_rows(t1, rn); const Rec rnn = ld_rec(t2);
            float v[16];
#pragma unroll
            for (int hh = 0; hh < 2; ++hh) { f32x4 x0, x1, a0, a1, b0, b1; unpk8(cur.x[hh], x0, x1); unpk8(cur.a[hh], a0, a1); unpk8(cur.b[hh], b0, b1);
#pragma unroll
                for (int j = 0; j < 4; ++j) { v[8 * hh + j] = ALPHA * x0[j] + rc.w1 * a0[j] + rc.w2 * b0[j]; v[8 * hh + 4 + j] = ALPHA * x1[j] + rc.w1 * a1[j] + rc.w2 * b1[j]; } }
            ln16(v, g, b, F.lane);
            store16(X2 + (size_t)t * D, F.lane, v);
            { float am = 0.f;
#pragma unroll
              for (int j = 0; j < 16; ++j) am = __builtin_fmaxf(am, __builtin_fabsf(v[j]));
              am = wave_max_pos(am);
              const int e = am > 0.f ? __builtin_amdgcn_frexp_expf(am) : 0; const float sc = __builtin_amdgcn_ldexpf(1.0f, 7 - e);
              u32x2 q0, q1; q0.x = pk4_fp8(v[0] * sc, v[1] * sc, v[2] * sc, v[3] * sc); q0.y = pk4_fp8(v[4] * sc, v[5] * sc, v[6] * sc, v[7] * sc);
              q1.x = pk4_fp8(v[8] * sc, v[9] * sc, v[10] * sc, v[11] * sc); q1.y = pk4_fp8(v[12] * sc, v[13] * sc, v[14] * sc, v[15] * sc);
              *(u32x2*)(X2Q + (size_t)t * D + 8 * F.lane) = q0; *(u32x2*)(X2Q + (size_t)t * D + 512 + 8 * F.lane) = q1;
              if (F.lane == 0) XS[t] = __builtin_amdgcn_ldexpf(1.0f, e - 7); }
            cur = nxt; rc = rn; rn = rnn;
        }
    }
}

typedef __amdgpu_buffer_rsrc_t rsrc_t;
DI rsrc_t mk_rsrc(const void* p, unsigned nbytes) { return __builtin_amdgcn_make_buffer_rsrc((void*)p, (short)0, (int)nbytes, 0x00020000); }
DI bf16x8 bload(rsrc_t r, unsigned voff, unsigned soff) { return __builtin_bit_cast(bf16x8, __builtin_amdgcn_raw_buffer_load_b128(r, (int)voff, (int)soff, 0)); }
DI bf16x8 mk_frag(f32x4 a, f32x4 b) { return __builtin_bit_cast(bf16x8, pk8(a, b)); }
#define MFMA16(a, b, c) __builtin_amdgcn_mfma_f32_16x16x32_bf16((a), (b), (c), 0, 0, 0)

struct ScanK { bf16x8 ka0[4], ka1[4]; };
DI void scan_load_k(ScanK& o, rsrc_t rk, int chunk, int h, int w, unsigned vl) {
    const unsigned ok = ((unsigned)chunk * D + (unsigned)(h * DK + 32 * w)) * (CH * 2);
#pragma unroll
    for (int kk = 0; kk < 4; ++kk) { o.ka0[kk] = bload(rk, vl, ok + kk * 1024); o.ka1[kk] = bload(rk, vl, ok + 4096 + kk * 1024); }
}
DI void scan_load_q(bf16x8 (&qf)[8], rsrc_t rq, int chunk, int h, int w, unsigned vl) {
    const unsigned oq = (((unsigned)chunk * 8u + (unsigned)w) * 128u + 4u * (unsigned)(h * 8)) * 256u;
#pragma unroll
    for (int kb = 0; kb < 8; ++kb) qf[kb] = bload(rq, vl, oq + kb * 1024);
}
DI void phase_ret_scan(Frame& F, const bf16_t* QP, const bf16_t* KT, const bf16_t* VT, bf16_t* CR, bf16_t* S32) {
    const int lane = F.lane, w = F.wave;
    LAS unsigned char* SB = F.lds + RING_OFF;
    LAS unsigned char* VS = F.lds + RING_OFF + 32768;
    constexpr int NC = SEQ / CH / 2;
    for (int item = F.vcu; item < NB * RH * 2 * 16; item += F.G) {
        const int es = item & 15, seg = (item >> 4) & 1, bh = item >> 5, bb = bh >> 2, h = bh & 3;
        const float gam = 1.0f - __builtin_amdgcn_exp2f(-5.0f - (float)h), lg2 = __log2f(gam);
        const float cd = __builtin_amdgcn_exp2f(128.0f * lg2), kd = __builtin_amdgcn_exp2f(127.0f * lg2);
        f32x4 R0[2] = {{0.f, 0.f, 0.f, 0.f}, {0.f, 0.f, 0.f, 0.f}}, R1[2] = {{0.f, 0.f, 0.f, 0.f}, {0.f, 0.f, 0.f, 0.f}};
        const int e0 = h * DV + es * 32, c0 = bb * (SEQ / CH) + seg * NC;
        const unsigned vl = (unsigned)lane * 16u;
        const rsrc_t rq = mk_rsrc(QP, (unsigned)M * D * 2u), rk = mk_rsrc(KT, (unsigned)M * D * 2u), rv = mk_rsrc(VT, (unsigned)M * VD * 2u);
        const unsigned vfo = (unsigned)(e0 + (w >> 2) * 16) * (CH * 2) + (unsigned)(w & 3) * 1024u;
        ScanK A, B; bf16x8 qf[8];
        scan_load_k(A, rk, c0, h, w, vl);
        bf16x8 vpre = bload(rv, vl, (unsigned)c0 * VD * (CH * 2) + vfo);
        scan_load_q(qf, rq, c0, h, w, vl);
        *(LAS bf16x8*)(VS + w * 1024 + vl) = vpre; vpre = bload(rv, vl, (unsigned)(c0 + 1) * VD * (CH * 2) + vfo);
        scan_load_k(B, rk, c0 + 1, h, w, vl);
        LDS_WAIT(); __builtin_amdgcn_s_barrier(); asm volatile("" ::: "memory");
#define SCAN_STEP(O, ci) do { \
            const int chunk = c0 + (ci); LAS unsigned char* sb = SB + ((ci) & 1) * 16384; const LAS unsigned char* vs = VS + ((ci) & 1) * 8192; \
            _Pragma("unroll") for (int eb = 0; eb < 2; ++eb) *(LAS bf16x8*)(sb + (eb * 8 + w) * 1024 + vl) = mk_frag(R0[eb] * gam, R1[eb] * gam); \
            f32x4 U0[2] = {{0.f, 0.f, 0.f, 0.f}, {0.f, 0.f, 0.f, 0.f}}, U1[2] = {{0.f, 0.f, 0.f, 0.f}, {0.f, 0.f, 0.f, 0.f}}; \
            _Pragma("unroll") for (int eb = 0; eb < 2; ++eb) _Pragma("unroll") for (int kk = 0; kk < 4; ++kk) { const bf16x8 vb = *(const LAS bf16x8*)(vs + (eb * 4 + kk) * 1024 + vl); \
                U0[eb] = MFMA16(O.ka0[kk], vb, U0[eb]); U1[eb] = MFMA16(O.ka1[kk], vb, U1[eb]); } \
            scan_load_k(O, rk, c0 + ((ci) + 2 < NC ? (ci) + 2 : NC - 1), h, w, vl); \
            *(LAS bf16x8*)(VS + (((ci) + 1) & 1) * 8192 + w * 1024 + vl) = vpre;          \
            vpre = bload(rv, vl, (unsigned)(c0 + ((ci) + 2 < NC ? (ci) + 2 : NC - 1)) * VD * (CH * 2) + vfo); \
            _Pragma("unroll") for (int eb = 0; eb < 2; ++eb) { R0[eb] = R0[eb] * cd + U0[eb] * kd; R1[eb] = R1[eb] * cd + U1[eb] * kd; } \
            LDS_WAIT(); __builtin_amdgcn_s_barrier(); asm volatile("" ::: "memory"); \
            _Pragma("unroll") for (int eb = 0; eb < 2; ++eb) { f32x4 t = {0.f, 0.f, 0.f, 0.f}; \
                _Pragma("unroll") for (int kb = 0; kb < 8; ++kb) t = MFMA16(*(const LAS bf16x8*)(sb + (eb * 8 + kb) * 1024 + vl), qf[kb], t); \
                u32x2 o; o.x = pk2(t[0], t[1]); o.y = pk2(t[2], t[3]); *(u32x2*)(CR + ((((size_t)chunk * 4 + h) * 8 + w) * 32 + (es * 2 + eb)) * 256 + lane * 4) = o; } \
            scan_load_q(qf, rq, c0 + ((ci) + 1 < NC ? (ci) + 1 : NC - 1), h, w, vl); } while (0)
        for (int ci = 0; ci < NC; ci += 2) { SCAN_STEP(A, ci); SCAN_STEP(B, ci + 1); }
#undef SCAN_STEP
        if (seg == 0) {
#pragma unroll
            for (int eb = 0; eb < 2; ++eb) *(bf16x8*)((char*)S32 + (((size_t)(bh * 32 + es * 2 + eb)) * 8 + w) * 1024 + vl) = mk_frag(R0[eb], R1[eb]);
        }
        LDS_WAIT(); __builtin_amdgcn_s_barrier(); asm volatile("" ::: "memory");
    }
}

DI void intra_dma8(LAS unsigned char* dst, const char* src, size_t blk_stride, int w, unsigned vl) {
#pragma unroll
    for (int i = 0; i < 8; ++i) __builtin_amdgcn_global_load_lds((const unsigned*)(src + (size_t)i * blk_stride + w * 1024 + vl), (LAS unsigned*)(dst + i * 8192 + w * 1024), 16, 0, 0);
}
DI void phase_ret_intra(Frame& F, const bf16_t* QP, const bf16_t* KP, const bf16_t* VT, const bf16_t* CR, const bf16_t* S32, bf16_t* GS, const bool dry, unsigned char* GS8, unsigned char* WQ, float* WQS) {
    { const int n = F.vcu * NWAVES + F.wave; if (n < D) quant_row_e4m3<2>((const bf16_t*)(F.ws + WS_WBOUT) + (size_t)n * VD, WQ + (size_t)n * VD, WQS + n, F.lane); }
    const int lane = F.lane, w = F.wave, l15 = lane & 15, q = lane >> 4;
    const unsigned vl = (unsigned)lane * 16u;
    LAS unsigned char* QB = F.lds + RING_OFF; LAS unsigned char* KB = F.lds + RING_OFF + 65536;
    for (int unit = F.vcu; unit < NB * RH * (SEQ / CH); unit += F.G) {
        const int h = (unit >> 6) & 3, bb = unit >> 8, ci = (unit & 63) ^ (bb << 5);
        const int chunk = bb * (SEQ / CH) + ci; const size_t tok0 = (size_t)chunk * CH; const size_t row = tok0 + 16 * w + l15;
        intra_dma8(QB, (const char*)QP + ((size_t)chunk * 8 * 128 + 32 * h) * 256, 128 * 256, w, vl);
        intra_dma8(KB, (const char*)KP + ((size_t)chunk * 8 * 128 + 32 * h) * 256, 128 * 256, w, vl);
        asm volatile("s_waitcnt vmcnt(0)" ::: "memory"); __builtin_amdgcn_s_barrier(); asm volatile("" ::: "memory");
        bf16x8 qb[8];
#pragma unroll
        for (int ks = 0; ks < 8; ++ks) qb[ks] = *(const LAS bf16x8*)(QB + w * 8192 + ks * 1024 + vl);
        const int nkp = (w >> 1) + 1, cl = 16 * w + l15;
        bf16x8 sfrag[4];
#pragma unroll
        for (int kp = 0; kp < 4; ++kp) {
            f32x4 st[2] = {{0.f, 0.f, 0.f, 0.f}, {0.f, 0.f, 0.f, 0.f}};
            if (kp < nkp) {
#pragma unroll
                for (int u2 = 0; u2 < 2; ++u2) {
                    f32x4 acc = {0.f, 0.f, 0.f, 0.f};
#pragma unroll
                    for (int ks = 0; ks < 8; ++ks) acc = MFMA16(*(const LAS bf16x8*)(KB + (2 * kp + u2) * 8192 + ks * 1024 + vl), qb[ks], acc);
#pragma unroll
                    for (int r = 0; r < 4; ++r) if (32 * kp + 8 * q + 4 * u2 + r > cl) acc[r] = 0.f;
                    st[u2] = acc;
                }
            }
            sfrag[kp] = mk_frag(st[0], st[1]);
        }
        asm volatile("s_waitcnt lgkmcnt(0)" ::: "memory"); __builtin_amdgcn_s_barrier(); asm volatile("" ::: "memory");
        { const char* vsrc = (const char*)VT + ((size_t)chunk * VD + h * DV) * (CH * 2);
          intra_dma8(QB, vsrc, 8192, w, vl); intra_dma8(KB, vsrc + 65536, 8192, w, vl); }
        u32x2 cpre[32];
#pragma unroll
        for (int eb = 0; eb < 32; ++eb) cpre[eb] = *(const u32x2*)(CR + ((((size_t)chunk * 4 + h) * 8 + w) * 32 + eb) * 256 + lane * 4);
        asm volatile("s_waitcnt vmcnt(0)" ::: "memory"); __builtin_amdgcn_s_barrier(); asm volatile("" ::: "memory");
        f32x4 acc[32];
#pragma unroll
        for (int eb = 0; eb < 32; ++eb) {
            f32x4 a4 = {0.f, 0.f, 0.f, 0.f};
            const LAS unsigned char* vb = (eb < 16 ? QB : KB) + (eb & 15) * 4096 + vl;
#pragma unroll
            for (int kp = 0; kp < 4; ++kp) if (kp < nkp) a4 = MFMA16(*(const LAS bf16x8*)(vb + kp * 1024), sfrag[kp], a4);
            acc[eb] = a4;
        }
#pragma unroll
        for (int eb = 0; eb < 32; ++eb) { const u32x2 cw = cpre[eb]; acc[eb] += (f32x4){bf_lo(cw.x), bf_hi(cw.x), bf_lo(cw.y), bf_hi(cw.y)}; }
        if (ci >= SEQ / CH / 2) {
            const float gam = 1.0f - __builtin_amdgcn_exp2f(-5.0f - (float)h), fc = gam * __builtin_amdgcn_exp2f((float)(128 * (ci - SEQ / CH / 2)) * __log2f(gam));
            bf16x8 qb2[8];
#pragma unroll
            for (int ks = 0; ks < 8; ++ks) qb2[ks] = *(const bf16x8*)((const char*)QP + (((size_t)chunk * 8 + w) * 128 + 4 * (h * 8 + ks)) * 256 + vl);
#pragma unroll
            for (int p = 0; p < 2; ++p) {
                asm volatile("s_waitcnt lgkmcnt(0)" ::: "memory"); __builtin_amdgcn_s_barrier(); asm volatile("" ::: "memory");
                { const char* ssrc = (const char*)S32 + ((size_t)((bb * RH + h) * 32 + 16 * p) * 8) * 1024; intra_dma8(QB, ssrc, 8192, w, vl); intra_dma8(KB, ssrc + 65536, 8192, w, vl); }
                asm volatile("s_waitcnt vmcnt(0)" ::: "memory"); __builtin_amdgcn_s_barrier(); asm volatile("" ::: "memory");
#pragma unroll
                for (int ebl = 0; ebl < 16; ++ebl) {
                    f32x4 t = {0.f, 0.f, 0.f, 0.f};
                    const LAS unsigned char* sbp = (ebl < 8 ? QB : KB) + (ebl & 7) * 8192 + vl;
#pragma unroll
                    for (int ks = 0; ks < 8; ++ks) t = MFMA16(*(const LAS bf16x8*)(sbp + ks * 1024), qb2[ks], t);
                    acc[16 * p + ebl] += t * fc;
                }
            }
        }
        u32x2 gpre[32];
#pragma unroll
        for (int eb = 0; eb < 32; ++eb) gpre[eb] = *(const u32x2*)(GS + row * VD + h * DV + eb * 16 + 4 * q);
        float s = 0.f;
#pragma unroll
        for (int eb = 0; eb < 32; ++eb) s += (acc[eb][0] + acc[eb][1]) + (acc[eb][2] + acc[eb][3]);
        s += shx(s, 16, lane); s += shx(s, 32, lane);
        const float mean = s * (1.0f / DV); float qq = 0.f;
#pragma unroll
        for (int eb = 0; eb < 32; ++eb) { acc[eb] -= mean; qq += (acc[eb][0] * acc[eb][0] + acc[eb][1] * acc[eb][1]) + (acc[eb][2] * acc[eb][2] + acc[eb][3] * acc[eb][3]); }
        qq += shx(qq, 16, lane); qq += shx(qq, 32, lane);
        const float rstd = __builtin_amdgcn_rsqf(qq * (1.0f / DV) + LN_EPS);
#pragma unroll
        for (int eb = 0; eb < 32; ++eb) { bf16_t* gp = GS + row * VD + h * DV + eb * 16 + 4 * q; const u32x2 gw = gpre[eb];
            const f32x4 o = acc[eb] * (rstd * H8S); (void)gp; if (!dry) *(unsigned*)(GS8 + row * VD + h * DV + eb * 16 + 4 * q) = pk4_fp8c(bf_lo(gw.x) * o[0], bf_hi(gw.x) * o[1], bf_lo(gw.y) * o[2], bf_hi(gw.y) * o[3]); }
        asm volatile("s_waitcnt lgkmcnt(0)" ::: "memory"); __builtin_amdgcn_s_barrier(); asm volatile("" ::: "memory");
    }
}

DI void sgu_dma(LAS unsigned char* dst, const char* src, int w, unsigned vl) {
#pragma unroll
    for (int i = 0; i < 8; ++i) __builtin_amdgcn_global_load_lds((const unsigned*)(src + i * 8192 + w * 1024 + vl), (LAS unsigned*)(dst + i * 8192 + w * 1024), 16, 0, 0);
}
DI void phase_sgu(Frame& F, CArgs* ap, bf16_t* U, const bf16_t* VT, const f32x2* ST, const bool dry, unsigned char* Y8, unsigned char* WQ, float* WQS) {
    const int lane = F.lane, w = F.wave, l15 = lane & 15, q = lane >> 4;
    { const int n = F.vcu * NWAVES + w; if (n < D) quant_row_e4m3<3>((const bf16_t*)(F.ws + WS_WCOUT) + (size_t)n * SH, WQ + (size_t)n * SH, WQS + n, lane); }
    LAS float* MU = (LAS float*)(F.lds + LDSCTL_OFF + 2048); LAS float* RS = MU + CH;
    LAS float* LGs = (LAS float*)(F.lds + LDSCTL_OFF + 4096); LAS float* LBs = LGs + SH;
    LAS unsigned char* VB = F.lds + RING_OFF;
    const unsigned vl = (unsigned)lane * 16u;
    const float* WS_ = (const float*)ap->in[I_CWS]; const float* BS = (const float*)ap->in[I_CBS];
    { const float* LG = (const float*)ap->in[I_CLNG]; const float* LB = (const float*)ap->in[I_CLNB];
      for (int i = F.tid; i < SH; i += NWAVES * 64) { LGs[i] = LG[i]; LBs[i] = LB[i]; } }
    const int NP = NCHUNK * 4, PP = (NP + F.G - 1) / F.G, p0 = F.vcu * PP, p1 = (p0 + PP < NP) ? p0 + PP : NP;
    int nprev = -1;
    for (int p = p0; p < p1; ++p) {
        const int g = p & 3, n = p >> 2;
        const int t = 16 * w + l15, nk = (w >> 1) + 1;
        asm volatile("s_waitcnt lgkmcnt(0)" ::: "memory"); __builtin_amdgcn_s_barrier(); asm volatile("" ::: "memory");
        sgu_dma(VB, (const char*)VT + ((size_t)n * SH + g * SGD) * (CH * 2), w, vl);
        u32x2 upre[16];
#pragma unroll
        for (int db = 0; db < 16; ++db) upre[db] = *(const u32x2*)(U + (size_t)(n * CH + t) * SH + g * SGD + db * 16 + 4 * q);
        if (n != nprev) {
            float ssum = 0.f, ssq = 0.f;
            if (F.tid < CH) { const f32x2* sp = ST + (size_t)(n * CH + F.tid) * 48;
#pragma unroll 8
                for (int j = 0; j < 48; ++j) { const f32x2 x = sp[j]; ssum += x.x; ssq += x.y; }
                const float mean = ssum * (1.0f / SH), var = ssq * (1.0f / SH) - mean * mean; MU[F.tid] = mean; RS[F.tid] = __builtin_amdgcn_rsqf(var + LN_EPS); }
            nprev = n;
        }
        const float* wrow = WS_ + ((size_t)g * CH + t) * CH;
        f32x4 wv[4][2];
#pragma unroll
        for (int kp = 0; kp < 4; ++kp) { if (kp < nk) { wv[kp][0] = *(const f32x4*)(wrow + 32 * kp + 8 * q); wv[kp][1] = *(const f32x4*)(wrow + 32 * kp + 8 * q + 4); } else { wv[kp][0] = wv[kp][1] = (f32x4){0.f, 0.f, 0.f, 0.f}; } }
        const float bs = BS[g * CH + t];
        asm volatile("s_waitcnt vmcnt(0) lgkmcnt(0)" ::: "memory"); __builtin_amdgcn_s_barrier(); asm volatile("" ::: "memory");
        bf16x8 af[4]; float c1 = 0.f, c2 = 0.f;
#pragma unroll
        for (int kp = 0; kp < 4; ++kp) {
            f32x4 v0 = {0.f, 0.f, 0.f, 0.f}, v1 = {0.f, 0.f, 0.f, 0.f};
            if (kp < nk) {
                const int s0 = 32 * kp + 8 * q; const f32x4 w0 = wv[kp][0], w1 = wv[kp][1];
#pragma unroll
                for (int j = 0; j < 4; ++j) {
                    if (s0 + j <= t) { c2 += w0[j]; v0[j] = bfr(w0[j] * RS[s0 + j]); c1 += v0[j] * MU[s0 + j]; }
                    if (s0 + 4 + j <= t) { c2 += w1[j]; v1[j] = bfr(w1[j] * RS[s0 + 4 + j]); c1 += v1[j] * MU[s0 + 4 + j]; }
                }
            }
            af[kp] = mk_frag(v0, v1);
        }
        c1 += shx(c1, 16, lane); c1 += shx(c1, 32, lane); c2 += shx(c2, 16, lane); c2 += shx(c2, 32, lane);
#pragma unroll
        for (int dt = 0; dt < 3; ++dt) {
            const int dbase = g * SGD + dt * 256; LAS unsigned char* vb = VB + (dt & 1) * 65536;
            u32x2 unext[16];
            if (dt < 2) {
                sgu_dma(VB + ((dt + 1) & 1) * 65536, (const char*)VT + ((size_t)n * SH + dbase + 256) * (CH * 2), w, vl);
#pragma unroll
                for (int db = 0; db < 16; ++db) unext[db] = *(const u32x2*)(U + (size_t)(n * CH + t) * SH + dbase + 256 + db * 16 + 4 * q);
            }
#pragma unroll
            for (int db = 0; db < 16; ++db) {
                f32x4 acc = {0.f, 0.f, 0.f, 0.f};
#pragma unroll
                for (int kp = 0; kp < 4; ++kp) if (kp < nk) acc = MFMA16(*(const LAS bf16x8*)(vb + db * 4096 + kp * 1024 + vl), af[kp], acc);
                const int dg = dbase + db * 16 + 4 * q;
                const f32x4 lg = *(const LAS f32x4*)(LGs + dg), lb = *(const LAS f32x4*)(LBs + dg);
                bf16_t* up = U + (size_t)(n * CH + t) * SH + dg; const u32x2 uw = upre[db];
                const f32x4 uu = {bf_lo(uw.x), bf_hi(uw.x), bf_lo(uw.y), bf_hi(uw.y)};
                const f32x4 y = uu * (lg * (acc - c1) + lb * c2 + bs);
                if (!dry) *(unsigned*)(Y8 + (size_t)(n * CH + t) * SH + dg) = pk4_fp8c(y[0] * H8S, y[1] * H8S, y[2] * H8S, y[3] * H8S); (void)up;
            }
            if (dt < 2) {
                asm volatile("s_waitcnt vmcnt(0) lgkmcnt(0)" ::: "memory"); __builtin_amdgcn_s_barrier(); asm volatile("" ::: "memory");
#pragma unroll
                for (int db = 0; db < 16; ++db) upre[db] = unext[db];
            }
        }
    }
    asm volatile("s_waitcnt lgkmcnt(0)" ::: "memory"); __builtin_amdgcn_s_barrier(); asm volatile("" ::: "memory");
}

DI void grid_sync(CArgs* ap, int wv) {
    extern __shared__ __attribute__((aligned(16))) unsigned char lds[];
    XcdBarrier b; b.bar = (unsigned*)(ap->ws + WS_CTL) + CW_BAR; b.x = xb_xcc_id(); b.st = (volatile LAS unsigned*)((LAS unsigned char*)lds + MISC_OFF) + 8;
    int t = cur_tid(wv); asm volatile("" : "+v"(t));
    xcd_barrier(b, t == 0);
}
#ifndef PROBE_DRY
#define PROBE_DRY 0
#endif
#ifndef PROBE_EXTRA_BARRIERS
#define PROBE_EXTRA_BARRIERS 0
#endif
#ifndef PROBE_DUP_MASK
#define PROBE_DUP_MASK 0ull
#endif
#define PHASE(k, ...) do { const int ph_ = (k); for (int rep_ = 0; rep_ < (((PROBE_DUP_MASK >> (k)) & 1ull) ? 2 : 1); ++rep_) { CArgs* ap = kargs(); if (ap->ph_lo <= ph_ && ph_ < ap->ph_hi) { { Frame F = mkframe(ap, wv); unsigned char* ws = F.ws; unsigned char* R = ws + WS_R; (void)R; __VA_ARGS__ } \
        if (!MK_MULTI) { CArgs* ap2 = kargs(); if (ph_ + 1 < ap2->ph_hi) grid_sync(ap2, wv); } } } } while (0)
#ifndef PROBE_DUP_MASK_NB
#define PROBE_DUP_MASK_NB 0ull
#endif
#define PHASE_NB(k, ...) do { const int ph_ = (k); for (int rep_ = 0; rep_ < (((PROBE_DUP_MASK_NB >> (k)) & 1ull) ? 2 : 1); ++rep_) { CArgs* ap = kargs(); if (ap->ph_lo <= ph_ && ph_ < ap->ph_hi) { Frame F = mkframe(ap, wv); unsigned char* ws = F.ws; unsigned char* R = ws + WS_R; (void)R; __VA_ARGS__ } } } while (0)
#define XB_OF(L) ((bf16_t*)(ws + (((L) & 1) ? WS_XQ : WS_XP)))
#define X1_OF(L) ((bf16_t*)(ws + (((L) & 1) ? WS_XP : WS_XQ)))

template <int L> DI void layer_body(const int wv) {
        constexpr int mixer = L % 3, pb = 1 + L * 10;
        if constexpr (mixer == 0) {
            PHASE(pb + 0, { const int slot = L / 3;
              pg8::Gemm g{XB_OF(L), (const bf16_t*)(ws + WS_WAIN) + (size_t)slot * 3072 * D, M, 3072, D}; pg8::StaticOrder S; S.init(M, 3072, F.G, F.bx);
              pg8::EpiAin E{(bf16_t*)(R + R_BG), (bf16_t*)(R + R_Z)};
              pg8::gemm_phase<pg8::EpiAin, pg8::StaticOrder, false>(F.lds + RING_OFF, g, S, E, F.tid); });
            PHASE(pb + 1, { const int slot = L / 3; phase_conv(F, (const bf16_t*)(R + R_BG), (const bf16_t*)(R + R_Z), (const float*)ap->in[I_ACONV] + (size_t)slot * 3 * D, R + R_YC, (const bf16_t*)(ws + WS_WAOUT) + (size_t)slot * D * D, R + R_AWQ, (float*)(R + R_AWQS)); });
        } else if constexpr (mixer == 1) {
            PHASE(pb + 0, {
              pg8::Gemm g{XB_OF(L), (const bf16_t*)(ws + WS_WBIN), M, 6144, D}; pg8::StaticOrder S; S.init(M, 6144, F.G, F.bx);
              pg8::EpiBin E{(bf16_t*)(R + R_QP), (bf16_t*)(R + R_KP), (bf16_t*)(R + R_KT), (bf16_t*)(R + R_VT), (bf16_t*)(R + R_GS), (const float*)(ws + WS_COS), (const float*)(ws + WS_SIN), F.lds + XPOSE_OFF};
              pg8::gemm_phase<pg8::EpiBin, pg8::StaticOrder, false>(F.lds + RING_OFF, g, S, E, F.tid); });
            PHASE(pb + 1, phase_ret_scan(F, (const bf16_t*)(R + R_QP), (const bf16_t*)(R + R_KT), (const bf16_t*)(R + R_VT), (bf16_t*)(R + R_CR), (bf16_t*)(ws + WS_S1)););
            if (PROBE_DRY & 1) PHASE(pb + 2, phase_ret_intra(F, (const bf16_t*)(R + R_QP), (const bf16_t*)(R + R_KP), (const bf16_t*)(R + R_VT), (const bf16_t*)(R + R_CR), (const bf16_t*)(ws + WS_S1), (bf16_t*)(R + R_GS), ap->ph_hi < 1000, R + R_KT, ws + WS_PB, (float*)(ws + WS_PB + 4 * MiB)););
            PHASE(pb + 2, phase_ret_intra(F, (const bf16_t*)(R + R_QP), (const bf16_t*)(R + R_KP), (const bf16_t*)(R + R_VT), (const bf16_t*)(R + R_CR), (const bf16_t*)(ws + WS_S1), (bf16_t*)(R + R_GS), false, R + R_KT, ws + WS_PB, (float*)(ws + WS_PB + 4 * MiB)););
        } else {
            PHASE(pb + 0, {
              pg8::Gemm g{XB_OF(L), (const bf16_t*)(ws + WS_WCIN), M, 6144, D}; pg8::StaticOrder S; S.init(M, 6144, F.G, F.bx);
              pg8::EpiCin E{(bf16_t*)(R + R_U), (bf16_t*)(R + R_CVT), (f32x2*)(R + R_ST), F.lds + XPOSE_OFF};
              pg8::gemm_phase<pg8::EpiCin, pg8::StaticOrder, false>(F.lds + RING_OFF, g, S, E, F.tid); });
            if (PROBE_DRY & 2) PHASE(pb + 1, phase_sgu(F, ap, (bf16_t*)(R + R_U), (const bf16_t*)(R + R_CVT), (const f32x2*)(R + R_ST), ap->ph_hi < 1000, R + R_Y8, R + R_WQ, (float*)(R + R_WQS)););
            PHASE(pb + 1, phase_sgu(F, ap, (bf16_t*)(R + R_U), (const bf16_t*)(R + R_CVT), (const f32x2*)(R + R_ST), false, R + R_Y8, R + R_WQ, (float*)(R + R_WQS)););
        }
        PHASE(pb + 3, { const int mx = L % 3, slot = L / 3;
          const bf16_t* WoA = (const bf16_t*)(R + (mx == 0 ? R_YC : mx == 1 ? R_GS : R_U));
          const bf16_t* WoB = mx == 0 ? (const bf16_t*)(ws + WS_WAOUT) + (size_t)slot * D * D : mx == 1 ? (const bf16_t*)(ws + WS_WBOUT) : (const bf16_t*)(ws + WS_WCOUT);
          const int WoK = mx == 0 ? D : mx == 1 ? VD : SH;
          pg8::StaticOrder S; S.init(M, D, F.G, F.bx);
          const unsigned char* A8 = mx == 0 ? R + R_YC : mx == 1 ? R + R_KT : R + R_Y8;
          const unsigned char* B8 = mx == 0 ? R + R_AWQ : mx == 1 ? ws + WS_PB : R + R_WQ;
          const float* C8 = mx == 0 ? (const float*)(R + R_AWQS) : mx == 1 ? (const float*)(ws + WS_PB + 4 * MiB) : (const float*)(R + R_WQS);
          (void)WoA; (void)WoB;
          pg8::Gemm g{(const bf16_t*)A8, (const bf16_t*)B8, M, D, WoK / 2};
          pg8::EpiS1 E{XB_OF(L), (bf16_t*)(ws + WS_S1), C8, mx == 0 ? 1.0f / YC8S : 1.0f / H8S};
          pg8::gemm_phase<pg8::EpiS1, pg8::StaticOrder, false, true>(F.lds + RING_OFF, g, S, E, F.tid); });
        if ((PROBE_DRY & 4) && L == 0) PHASE(pb + 4, phase_ln1_route(F, ap, L, (const bf16_t*)(ws + WS_S1), X1_OF(L), ap->ph_hi < 1000, R + R_X2););
        PHASE(pb + 4, phase_ln1_route(F, ap, L, (const bf16_t*)(ws + WS_S1), X1_OF(L), false, R + R_X2););
#define MOE_SCHED(S, LISTP, ESTR) pg8::MoeOrder S; S.tab = (const LAS int*)(F.lds + TAB_OFF); S.G = F.G; S.c = F.vcu; S.list = (LISTP); S.nN = 4; S.nshift = 2; S.estride = (ESTR); S.rdy = nullptr; S.apitch = 2048u; \
          const int total_ = S.tab[16] * 4, U1_ = total_ < 2 * F.G ? total_ : 2 * F.G, n1_ = total_ - U1_; (void)n1_;
        PHASE_NB(pb + 5, { moe_table(F, L);
          const bool f8 = (F.G * NWAVES == 2048);
          const float* RSC = (const float*)((const int*)(ws + WS_ROUTE) + 6 * M + 16 * M); const float* CSC = (const float*)(ws + WS_WGU + 16 * MiB);
          if (f8) { pg8::Gemm g{(const bf16_t*)(R + R_X2), (const bf16_t*)(ws + WS_WGU), NSLOT, 1024, D / 2};
            MOE_SCHED(S, (const int*)(ws + WS_ROUTE) + 6 * M, (size_t)1024 * D); S.apitch = 1024u; S.range(0, U1_, 0, 0);
            pg8::EpiMoe1 E{(bf16_t*)(R + R_H), F.ctl + CW_RDY + L * 256, F.ctl + CW_AGG + (L * 2) * 1024, xb_xcc_id(), MK_MULTI ? 0u : ((volatile LAS unsigned*)(F.lds + MISC_OFF))[8], RSC, CSC, (const LAS int*)(F.lds + TAB_OFF)};
            pg8::gemm_phase<pg8::EpiMoe1, pg8::MoeOrder, true, true>(F.lds + RING_OFF, g, S, E, F.tid);
          } else { pg8::Gemm g{X1_OF(L), (const bf16_t*)(ws + WS_WGU), NSLOT, 1024, D};
            MOE_SCHED(S, (const int*)(ws + WS_ROUTE) + 6 * M, (size_t)1024 * D * 2); S.range(0, U1_, 0, 0);
            pg8::EpiMoe1 E{(bf16_t*)(R + R_H), F.ctl + CW_RDY + L * 256, F.ctl + CW_AGG + (L * 2) * 1024, xb_xcc_id(), MK_MULTI ? 0u : ((volatile LAS unsigned*)(F.lds + MISC_OFF))[8], nullptr, nullptr, nullptr};
            pg8::gemm_phase<pg8::EpiMoe1, pg8::MoeOrder, true>(F.lds + RING_OFF, g, S, E, F.tid); } });
        PHASE_NB(pb + 6, { if (MK_MULTI) moe_table(F, L);
          const bool f8 = (F.G * NWAVES == 2048);
          const float* RSC = (const float*)((const int*)(ws + WS_ROUTE) + 6 * M + 16 * M); const float* CSC = (const float*)(ws + WS_WGU + 16 * MiB);
          if (f8) { pg8::Gemm g{(const bf16_t*)(R + R_X2), (const bf16_t*)(ws + WS_WGU), NSLOT, 1024, D / 2};
            MOE_SCHED(S, (const int*)(ws + WS_ROUTE) + 6 * M, (size_t)1024 * D); S.apitch = 1024u; S.c = moe_c2(F, n1_); S.range(U1_, total_, 0, 0);
            pg8::EpiMoe1 E{(bf16_t*)(R + R_H), F.ctl + CW_RDY + L * 256, nullptr, 0u, 0u, RSC, CSC, (const LAS int*)(F.lds + TAB_OFF)};
            pg8::gemm_phase<pg8::EpiMoe1, pg8::MoeOrder, true, true>(F.lds + RING_OFF, g, S, E, F.tid);
          } else { pg8::Gemm g{X1_OF(L), (const bf16_t*)(ws + WS_WGU), NSLOT, 1024, D};
            MOE_SCHED(S, (const int*)(ws + WS_ROUTE) + 6 * M, (size_t)1024 * D * 2); S.c = moe_c2(F, n1_); S.range(U1_, total_, 0, 0);
            pg8::EpiMoe1 E{(bf16_t*)(R + R_H), F.ctl + CW_RDY + L * 256, nullptr, 0u, 0u, nullptr, nullptr, nullptr};
            pg8::gemm_phase<pg8::EpiMoe1, pg8::MoeOrder, true>(F.lds + RING_OFF, g, S, E, F.tid); } });
        PHASE_NB(pb + 6, {
          const bool f8 = (F.G * NWAVES == 2048); const float* CSD = (const float*)(ws + WS_WDN + 8 * MiB);
          pg8::Gemm g{(const bf16_t*)(R + R_H), (const bf16_t*)(ws + WS_WDN), NSLOT, D, f8 ? DE / 2 : DE};
          MOE_SCHED(S, nullptr, f8 ? (size_t)D * DE : (size_t)D * DE * 2); S.rdy = F.ctl + CW_RDY + L * 256; S.c = moe_c2(F, n1_); const int U2_ = (n1_ < F.G && 2 * (F.G - n1_) < U1_) ? 2 * (F.G - n1_) : U1_; S.range(0, U2_, n1_, 1);
          pg8::EpiPlain E{(bf16_t*)(R + R_YS), D, f8 ? CSD : nullptr, 1.0f / H8S};
          if (f8) pg8::gemm_phase<pg8::EpiPlain, pg8::MoeOrder, false, true>(F.lds + RING_OFF, g, S, E, F.tid);
          else pg8::gemm_phase<pg8::EpiPlain, pg8::MoeOrder, false>(F.lds + RING_OFF, g, S, E, F.tid); });
        PHASE_NB(pb + 7, { if (MK_MULTI) moe_table(F, L);
          const bool f8 = (F.G * NWAVES == 2048); const float* CSD = (const float*)(ws + WS_WDN + 8 * MiB);
          pg8::Gemm g{(const bf16_t*)(R + R_H), (const bf16_t*)(ws + WS_WDN), NSLOT, D, f8 ? DE / 2 : DE};
          MOE_SCHED(S, nullptr, f8 ? (size_t)D * DE : (size_t)D * DE * 2); S.rdy = F.ctl + CW_RDY + L * 256; S.c = moe_c2(F, n1_); const int U2_ = (n1_ < F.G && 2 * (F.G - n1_) < U1_) ? 2 * (F.G - n1_) : U1_; S.range(U2_, total_, 0, 0);
          pg8::EpiPlain E{(bf16_t*)(R + R_YS), D, f8 ? CSD : nullptr, 1.0f / H8S};
          if (f8) pg8::gemm_phase<pg8::EpiPlain, pg8::MoeOrder, false, true>(F.lds + RING_OFF, g, S, E, F.tid);
          else pg8::gemm_phase<pg8::EpiPlain, pg8::MoeOrder, false>(F.lds + RING_OFF, g, S, E, F.tid); });
        PHASE(pb + 7, {
          const LAS int* tabp = (const LAS int*)(F.lds + TAB_OFF); const int total_ = tabp[16] * 4, U1_ = total_ < 2 * F.G ? total_ : 2 * F.G, n1_ = total_ - U1_;
          pg8::Gemm g{(const bf16_t*)(ws + WS_PB), (const bf16_t*)(ws + WS_WPROJ) + (size_t)L * D * PLE, M, D, PLE}; const int U2_ = (n1_ < F.G && 2 * (F.G - n1_) < U1_) ? 2 * (F.G - n1_) : U1_; pg8::SkipOrder S; S.init2(M, D, F.G, moe_c2(F, n1_), total_ - U2_);
          pg8::EpiPlain E{(bf16_t*)(R + R_EMB), D, nullptr, 1.0f};
          pg8::gemm_phase<pg8::EpiPlain, pg8::SkipOrder, false>(F.lds + RING_OFF, g, S, E, F.tid); });
        PHASE(pb + 8, { if (MK_MULTI) moe_table(F, L); phase_ln2(F, ap, L, X1_OF(L), (const bf16_t*)(R + R_YS), (bf16_t*)(R + R_X2), R + R_X2Q, (float*)(R + R_XS), R + R_WGQ, (float*)(R + R_CS)); });
        PHASE(pb + 9, {
          pg8::Gemm g{(const bf16_t*)(R + R_X2Q), (const bf16_t*)(R + R_WGQ), M, D, D / 2}; pg8::StaticOrder S; S.init(M, D, F.G, F.bx);
          pg8::EpiPle E{(const bf16_t*)(R + R_X2), (const bf16_t*)(R + R_EMB), (const float*)ap->in[I_PBG] + (size_t)L * D, X1_OF(L), ap->out, L == DEPTH - 1 ? 1 : 0, (const float*)(R + R_XS), (const float*)(R + R_CS)};
          pg8::gemm_phase<pg8::EpiPle, pg8::StaticOrder, false, true>(F.lds + RING_OFF, g, S, E, F.tid); });
}
__global__ void __launch_bounds__(NWAVES * 64, 2) mega_fwd(Args args) {
    extern __shared__ __attribute__((aligned(16))) unsigned char lds[];
    (void)args;
    const int wv = __builtin_amdgcn_readfirstlane((int)threadIdx.x >> 6);
    for (int u = threadIdx.x; u < (LDS_BYTES - LDSCTL_OFF) / 4; u += NWAVES * 64) ((LAS unsigned*)((LAS unsigned char*)lds + LDSCTL_OFF))[u] = 0u;
    __syncthreads();
    if (!MK_MULTI) { CArgs* ap = kargs(); (void)xcd_barrier_post((unsigned*)(ap->ws + WS_CTL) + CW_BAR, (volatile LAS unsigned*)((LAS unsigned char*)lds + MISC_OFF) + 8, threadIdx.x == 0); }

    PHASE(0, p0_prologue(F, ap););

    if (PROBE_EXTRA_BARRIERS) { for (int i = 0; i < PROBE_EXTRA_BARRIERS; ++i) { CArgs* apx = kargs(); grid_sync(apx, wv); } }
    layer_body<0>(wv); layer_body<1>(wv); layer_body<2>(wv); layer_body<3>(wv);
}
constexpr int NPHASES = 1 + DEPTH * 10;

extern "C" void kernel_launch(void* const* d_in, const int* in_sizes, int n_in, void* d_out, int out_size, void* d_ws, size_t ws_size, hipStream_t stream) {
    static int grid = 0;
    if (grid == 0) {
        if (n_in != 23 || out_size != M * D || ws_size < WS_END) { fprintf(stderr, "kernel_launch: unexpected problem (n_in %d, out %d, ws %zu)\n", n_in, out_size, ws_size); grid = -1; return; }
        int dev = 0, cus = 0, per_cu = 0;
        if (hipGetDevice(&dev) != hipSuccess || hipDeviceGetAttribute(&cus, hipDeviceAttributeMultiprocessorCount, dev) != hipSuccess) { grid = -1; return; }
        if (hipFuncSetAttribute((const void*)mega_fwd, hipFuncAttributeMaxDynamicSharedMemorySize, LDS_BYTES) != hipSuccess) { fprintf(stderr, "kernel_launch: hipFuncSetAttribute failed\n"); grid = -1; return; }
        if (hipOccupancyMaxActiveBlocksPerMultiprocessor(&per_cu, (const void*)mega_fwd, NWAVES * 64, LDS_BYTES) != hipSuccess || per_cu < 1) { fprintf(stderr, "kernel_launch: occupancy query says %d\n", per_cu); }
        (void)hipGetLastError();
        grid = cus;
    }
    if (grid < 0) return;
    (void)hipMemsetAsync((char*)d_ws + WS_CTL, 0, CTL_ZERO_BYTES, stream);
    Args a{};
    for (int i = 0; i < 23; ++i) a.in[i] = d_in[i];
    a.out = (float*)d_out; a.ws = (unsigned char*)d_ws;
#if MK_MULTI
    for (int p = 0; p < NPHASES; ++p) { a.ph_lo = p; a.ph_hi = p + 1; hipLaunchKernelGGL(mega_fwd, dim3(grid), dim3(NWAVES * 64), LDS_BYTES, stream, a); }
#else
    a.ph_lo = 0; a.ph_hi = NPHASES;
    hipLaunchKernelGGL(mega_fwd, dim3(grid), dim3(NWAVES * 64), LDS_BYTES, stream, a);
#endif
}
```
